# Optimizing an MI355X kernel written in HIP

```python
import math
import jax, jax.numpy as jnp
from jax import lax
import numpy as np

D_MODEL = 2048
BATCH = 4
SEQ = 4096
DEPTH = 4

D_FF = 5632
NORM_EPS = 1e-5
NEG_INF = -1e30
A_HEADS = 16
A_KV_HEADS = 4
HEAD_DIM = 64
WINDOW = 128
ATTN_BLOCK = 128
ROPE_THETA = 500000.0
ROPE_DIM = HEAD_DIM // 4
A_WIDTH = A_HEADS * HEAD_DIM
KV_WIDTH = A_KV_HEADS * HEAD_DIM
S5_WIDTH = D_MODEL // 2
S5_GROUP = 16
S5_GROUPS = S5_WIDTH // S5_GROUP
S5_STATE = 64
EVEN_IN = A_WIDTH + 2 * KV_WIDTH + S5_WIDTH
EVEN_OUT = A_WIDTH + S5_WIDTH
M_INNER = 2 * D_MODEL
M_HEAD_DIM = 64
M_HEADS = M_INNER // M_HEAD_DIM
M_GROUPS = 8
M_STATE = 128
M_CONV = 4
M_CHUNK = 128
M_CONV_DIM = M_INNER + 2 * M_GROUPS * M_STATE
M_IN = M_INNER + M_CONV_DIM + M_HEADS
N_EVEN = (DEPTH + 1) // 2
N_ODD = DEPTH // 2

kernel_name = "hybrid_swa_s5_ssd_macaron"


def rms_norm(x, g):
    xf = x.astype(jnp.float32)
    xf = xf * lax.rsqrt(jnp.mean(xf * xf, axis=-1, keepdims=True) + NORM_EPS)
    return xf.astype(x.dtype) * g


def swiglu_ffn(x, w_gate, w_up, w_down):
    return (jax.nn.silu(x @ w_gate) * (x @ w_up)) @ w_down


def partial_rotary(t, positions):
    half = ROPE_DIM // 2
    inv_freq = jnp.exp(-math.log(ROPE_THETA) * jnp.arange(half, dtype=jnp.float32) * (2.0 / ROPE_DIM))
    ang = positions.astype(jnp.float32)[:, :, None] * inv_freq
    cos = jnp.cos(ang)[:, :, None, :]
    sin = jnp.sin(ang)[:, :, None, :]
    tr = t[..., :ROPE_DIM].astype(jnp.float32)
    t1, t2 = tr[..., :half], tr[..., half:]
    rot = jnp.concatenate([t1 * cos - t2 * sin, t2 * cos + t1 * sin], axis=-1).astype(t.dtype)
    return jnp.concatenate([rot, t[..., ROPE_DIM:]], axis=-1)


def sliding_window_attention(q, k, v, sinks):
    b, s, _, hd = q.shape
    nb = s // ATTN_BLOCK
    grp = A_HEADS // A_KV_HEADS
    qb = q.reshape(b, nb, ATTN_BLOCK, A_KV_HEADS, grp, hd)

    def banded(t):
        tp = jnp.pad(t, ((0, 0), (ATTN_BLOCK, 0), (0, 0), (0, 0)))
        prev = tp[:, :s].reshape(b, nb, ATTN_BLOCK, A_KV_HEADS, hd)
        cur = t.reshape(b, nb, ATTN_BLOCK, A_KV_HEADS, hd)
        return jnp.concatenate([prev, cur], axis=2)

    kb, vb = banded(k), banded(v)
    scores = jnp.einsum('bnqhgd,bnchd->bnhgqc', qb, kb).astype(jnp.float32) * (1.0 / math.sqrt(hd))
    qpos = jnp.arange(ATTN_BLOCK)[:, None] + ATTN_BLOCK
    cpos = jnp.arange(2 * ATTN_BLOCK)[None, :]
    rel = qpos - cpos
    band = (rel >= 0) & (rel < WINDOW)
    blk_start = jnp.arange(nb)[:, None, None] * ATTN_BLOCK
    valid = band[None] & (blk_start + cpos[None] - ATTN_BLOCK >= 0)
    scores = jnp.where(valid[None, :, None, None], scores, NEG_INF)
    sink = sinks.astype(jnp.float32).reshape(A_KV_HEADS, grp)[None, None, :, :, None, None]
    sink = jnp.broadcast_to(sink, scores.shape[:-1] + (1,))
    probs = jax.nn.softmax(jnp.concatenate([scores, sink], axis=-1), axis=-1)[..., :-1]
    out = jnp.einsum('bnhgqc,bnchd->bnqhgd', probs.astype(v.dtype), vb)
    return out.reshape(b, s, A_HEADS * hd)


def s5_mixer(u, a_re, a_im, log_dt, b_re, b_im, c_re, c_im, d_skip, w_glu, b_glu):
    f32 = jnp.float32
    bsz, s, _ = u.shape
    uf = u.astype(f32).reshape(bsz, s, S5_GROUPS, S5_GROUP)
    are, aim = a_re.astype(f32), a_im.astype(f32)
    dt = jnp.exp(log_dt.astype(f32))[:, None]
    mag = jnp.exp(are * dt)
    abar_re, abar_im = mag * jnp.cos(aim * dt), mag * jnp.sin(aim * dt)
    nr, ni = abar_re - 1.0, abar_im
    den = are * are + aim * aim
    coef_re = (nr * are + ni * aim) / den
    coef_im = (ni * are - nr * aim) / den
    bre, bim = b_re.astype(f32), b_im.astype(f32)
    bbar_re = coef_re[..., None] * bre - coef_im[..., None] * bim
    bbar_im = coef_re[..., None] * bim + coef_im[..., None] * bre
    bu_re = jnp.einsum('gpc,bsgc->bsgp', bbar_re, uf)
    bu_im = jnp.einsum('gpc,bsgc->bsgp', bbar_im, uf)
    a_re_t = jnp.broadcast_to(abar_re, (s, S5_GROUPS, S5_STATE))
    a_im_t = jnp.broadcast_to(abar_im, (s, S5_GROUPS, S5_STATE))

    def combine(left, right):
        a1r, a1i, b1r, b1i = left
        a2r, a2i, b2r, b2i = right
        return (a1r * a2r - a1i * a2i, a1r * a2i + a1i * a2r,
                a2r * b1r - a2i * b1i + b2r, a2r * b1i + a2i * b1r + b2i)

    def scan_one(br, bi):
        _, _, hr, hi = lax.associative_scan(combine, (a_re_t, a_im_t, br, bi), axis=0)
        return hr, hi

    h_re, h_im = jax.vmap(scan_one)(bu_re, bu_im)
    y = (jnp.einsum('gcp,bsgp->bsgc', c_re.astype(f32), h_re)
         - jnp.einsum('gcp,bsgp->bsgc', c_im.astype(f32), h_im))
    y = (y + d_skip.astype(f32) * uf).reshape(bsz, s, S5_WIDTH)
    g = jax.nn.gelu(y)
    out = g * jax.nn.sigmoid(g @ w_glu.astype(f32) + b_glu.astype(f32))
    return out.astype(u.dtype)


def attn_s5_mixer(h, positions, w_in, sinks, a_re, a_im, log_dt, b_re, b_im, c_re, c_im,
                  d_skip, w_glu, b_glu, w_out):
    b, s, _ = h.shape
    proj = h @ w_in
    q = proj[..., :A_WIDTH].reshape(b, s, A_HEADS, HEAD_DIM)
    k = proj[..., A_WIDTH:A_WIDTH + KV_WIDTH].reshape(b, s, A_KV_HEADS, HEAD_DIM)
    v = proj[..., A_WIDTH + KV_WIDTH:A_WIDTH + 2 * KV_WIDTH].reshape(b, s, A_KV_HEADS, HEAD_DIM)
    u = proj[..., A_WIDTH + 2 * KV_WIDTH:]
    q = partial_rotary(q, positions)
    k = partial_rotary(k, positions)
    attn = sliding_window_attention(q, k, v, sinks)
    ssm = s5_mixer(u, a_re, a_im, log_dt, b_re, b_im, c_re, c_im, d_skip, w_glu, b_glu)
    return jnp.concatenate([attn, ssm], axis=-1) @ w_out


def ssd_chunked(x, dt, a, bm, cm):
    bsz, s, _, p = x.shape
    nc = s // M_CHUNK
    hpg = M_HEADS // M_GROUPS
    xc = (x * dt[..., None]).reshape(bsz, nc, M_CHUNK, M_GROUPS, hpg, p)
    bc = bm.reshape(bsz, nc, M_CHUNK, M_GROUPS, M_STATE)
    cc = cm.reshape(bsz, nc, M_CHUNK, M_GROUPS, M_STATE)
    adt = (a * dt).reshape(bsz, nc, M_CHUNK, M_GROUPS, hpg).transpose(0, 1, 3, 4, 2)
    a_cum = jnp.cumsum(adt, axis=-1)
    seg = a_cum[..., :, None] - a_cum[..., None, :]
    causal = jnp.tril(jnp.ones((M_CHUNK, M_CHUNK), dtype=bool))
    decay = jnp.exp(jnp.where(causal, seg, -jnp.inf))
    cb = jnp.einsum('bclgn,bcsgn->bcgls', cc, bc)
    y_diag = jnp.einsum('bcgls,bcgjls,bcsgjp->bclgjp', cb, decay, xc)
    decay_states = jnp.exp(a_cum[..., -1:] - a_cum)
    states = jnp.einsum('bclgn,bcgjl,bclgjp->bcgjpn', bc, decay_states, xc)
    chunk_decay = jnp.exp(a_cum[..., -1])

    def step(carry, inp):
        st, dec = inp
        return carry * dec[..., None, None] + st, carry

    init = jnp.zeros((bsz, M_GROUPS, hpg, p, M_STATE), jnp.float32)
    _, prev = lax.scan(step, init, (jnp.moveaxis(states, 1, 0), jnp.moveaxis(chunk_decay, 1, 0)))
    prev = jnp.moveaxis(prev, 0, 1)
    y_off = jnp.einsum('bclgn,bcgjpn,bcgjl->bclgjp', cc, prev, jnp.exp(a_cum))
    return (y_diag + y_off).reshape(bsz, s, M_HEADS, p)


def mamba2_mixer(h, w_in, conv_w, conv_b, dt_bias, a_log, d_skip, norm_g, w_out):
    f32 = jnp.float32
    bsz, s, _ = h.shape
    zxbcdt = h @ w_in
    z = zxbcdt[..., :M_INNER]
    xbc = zxbcdt[..., M_INNER:M_INNER + M_CONV_DIM]
    dt_raw = zxbcdt[..., M_INNER + M_CONV_DIM:]
    xpad = jnp.pad(xbc, ((0, 0), (M_CONV - 1, 0), (0, 0)))
    conv = conv_b
    for tap in range(M_CONV):
        conv = conv + conv_w[tap] * xpad[:, tap:tap + s]
    xbc = jax.nn.silu(conv)
    xs = xbc[..., :M_INNER].reshape(bsz, s, M_HEADS, M_HEAD_DIM).astype(f32)
    bm = xbc[..., M_INNER:M_INNER + M_GROUPS * M_STATE].reshape(bsz, s, M_GROUPS, M_STATE).astype(f32)
    cm = xbc[..., M_INNER + M_GROUPS * M_STATE:].reshape(bsz, s, M_GROUPS, M_STATE).astype(f32)
    dt = jax.nn.softplus(dt_raw.astype(f32) + dt_bias.astype(f32))
    a = -jnp.exp(a_log.astype(f32))
    y = ssd_chunked(xs, dt, a, bm, cm) + d_skip.astype(f32)[:, None] * xs
    y = y.reshape(bsz, s, M_INNER) * jax.nn.silu(z.astype(f32))
    y = y.reshape(bsz, s, M_GROUPS, M_INNER // M_GROUPS)
    y = y * lax.rsqrt(jnp.mean(y * y, axis=-1, keepdims=True) + NORM_EPS)
    y = y.reshape(bsz, s, M_INNER).astype(h.dtype) * norm_g
    return y @ w_out


def setup_inputs(seed: int = 0) -> dict:
    key = jax.random.key(seed)
    ks = iter(jax.random.split(key, 48))
    f32 = jnp.float32

    def nrm(shape, scale):
        return jax.random.normal(next(ks), shape, f32) * scale

    def gain(shape):
        return 1.0 + nrm(shape, 0.02)

    x = jax.random.normal(next(ks), (BATCH, SEQ, D_MODEL), f32)
    positions = jnp.broadcast_to(jnp.arange(SEQ, dtype=jnp.int32)[None, :], (BATCH, SEQ))
    a_im0 = jnp.pi * jnp.arange(S5_STATE, dtype=f32)
    dt0 = jnp.exp(jax.random.uniform(next(ks), (N_ODD, M_HEADS), f32, math.log(1e-3), math.log(1e-1)))
    return {
        "x": x,
        "positions": positions,
        "norm_ffn1": gain((DEPTH, D_MODEL)),
        "ffn1_gate": nrm((DEPTH, D_MODEL, D_FF), D_MODEL ** -0.5),
        "ffn1_up": nrm((DEPTH, D_MODEL, D_FF), D_MODEL ** -0.5),
        "ffn1_down": nrm((DEPTH, D_FF, D_MODEL), D_FF ** -0.5),
        "norm_mix": gain((DEPTH, D_MODEL)),
        "norm_ffn2": gain((DEPTH, D_MODEL)),
        "ffn2_gate": nrm((DEPTH, D_MODEL, D_FF), D_MODEL ** -0.5),
        "ffn2_up": nrm((DEPTH, D_MODEL, D_FF), D_MODEL ** -0.5),
        "ffn2_down": nrm((DEPTH, D_FF, D_MODEL), D_FF ** -0.5),
        "ev_w_in": nrm((N_EVEN, D_MODEL, EVEN_IN), D_MODEL ** -0.5),
        "ev_sinks": nrm((N_EVEN, A_HEADS), 0.5),
        "s5_a_re": -0.5 + nrm((N_EVEN, S5_GROUPS, S5_STATE), 0.01),
        "s5_a_im": a_im0 + nrm((N_EVEN, S5_GROUPS, S5_STATE), 0.01),
        "s5_log_dt": jax.random.uniform(next(ks), (N_EVEN, S5_GROUPS), f32, math.log(1e-3), math.log(1e-1)),
        "s5_b_re": nrm((N_EVEN, S5_GROUPS, S5_STATE, S5_GROUP), (2 * S5_GROUP) ** -0.5),
        "s5_b_im": nrm((N_EVEN, S5_GROUPS, S5_STATE, S5_GROUP), (2 * S5_GROUP) ** -0.5),
        "s5_c_re": nrm((N_EVEN, S5_GROUPS, S5_GROUP, S5_STATE), S5_STATE ** -0.5),
        "s5_c_im": nrm((N_EVEN, S5_GROUPS, S5_GROUP, S5_STATE), S5_STATE ** -0.5),
        "s5_d": nrm((N_EVEN, S5_GROUPS, S5_GROUP), 1.0),
        "s5_w_glu": nrm((N_EVEN, S5_WIDTH, S5_WIDTH), S5_WIDTH ** -0.5),
        "s5_b_glu": nrm((N_EVEN, S5_WIDTH), 0.01),
        "ev_w_out": nrm((N_EVEN, EVEN_OUT, D_MODEL), EVEN_OUT ** -0.5),
        "m_w_in": nrm((N_ODD, D_MODEL, M_IN), D_MODEL ** -0.5),
        "m_conv_w": nrm((N_ODD, M_CONV, M_CONV_DIM), M_CONV ** -0.5),
        "m_conv_b": nrm((N_ODD, M_CONV_DIM), 0.01),
        "m_dt_bias": dt0 + jnp.log(-jnp.expm1(-dt0)),
        "m_a_log": jnp.log(jax.random.uniform(next(ks), (N_ODD, M_HEADS), f32, 1.0, 16.0)),
        "m_d": gain((N_ODD, M_HEADS)),
        "m_norm": gain((N_ODD, M_INNER)),
        "m_w_out": nrm((N_ODD, M_INNER, D_MODEL), M_INNER ** -0.5),
        "final_norm": gain((D_MODEL,)),
    }


def reference(x, positions, norm_ffn1, ffn1_gate, ffn1_up, ffn1_down, norm_mix,
              norm_ffn2, ffn2_gate, ffn2_up, ffn2_down,
              ev_w_in, ev_sinks, s5_a_re, s5_a_im, s5_log_dt, s5_b_re, s5_b_im,
              s5_c_re, s5_c_im, s5_d, s5_w_glu, s5_b_glu, ev_w_out,
              m_w_in, m_conv_w, m_conv_b, m_dt_bias, m_a_log, m_d, m_norm, m_w_out,
              final_norm):
    for layer in range(DEPTH):
        x = x + 0.5 * swiglu_ffn(rms_norm(x, norm_ffn1[layer]), ffn1_gate[layer], ffn1_up[layer], ffn1_down[layer])
        hn = rms_norm(x, norm_mix[layer])
        if layer % 2 == 0:
            e = layer // 2
            mix = attn_s5_mixer(hn, positions, ev_w_in[e], ev_sinks[e], s5_a_re[e], s5_a_im[e],
                                s5_log_dt[e], s5_b_re[e], s5_b_im[e], s5_c_re[e], s5_c_im[e],
                                s5_d[e], s5_w_glu[e], s5_b_glu[e], ev_w_out[e])
        else:
            o = layer // 2
            mix = mamba2_mixer(hn, m_w_in[o], m_conv_w[o], m_conv_b[o], m_dt_bias[o], m_a_log[o],
                               m_d[o], m_norm[o], m_w_out[o])
        x = x + mix
        x = x + 0.5 * swiglu_ffn(rms_norm(x, norm_ffn2[layer]), ffn2_gate[layer], ffn2_up[layer], ffn2_down[layer])
    return rms_norm(x, final_norm)
```

```cpp
#include <hip/hip_runtime.h>
#include <cstdio>
#include <cstdint>

#ifndef MK_ONE_LAUNCH
#define MK_ONE_LAUNCH 1
#endif

#ifndef PROBE_MASK
#define PROBE_MASK 0
#endif
#ifndef USE_MFMA_ATTN
#define USE_MFMA_ATTN 1
#endif
#ifndef USE_MFMA_S5
#define USE_MFMA_S5 1
#endif
#ifndef USE_MFMA_SSD
#define USE_MFMA_SSD 1
#endif

constexpr int D_MODEL = 2048, BATCH = 4, SEQ = 4096, DEPTH = 4, M_TOK = BATCH * SEQ;
constexpr int D_FF = 5632;
constexpr float NORM_EPS = 1e-5f;
constexpr int A_HEADS = 16, A_KV = 4, HD = 64, WINDOW = 128;
constexpr int A_WIDTH = 1024, KV_WIDTH = 256, S5_WIDTH = 1024, S5_GROUP = 16, S5_GROUPS = 64, S5_STATE = 64;
constexpr int EVEN_IN = 2560;
constexpr int M_INNER = 4096, M_HEADS = 64, M_GROUPS = 8, M_STATE = 128, M_CONV_DIM = 6144, M_IN = 10304, M_IN_PAD = 10496;

namespace pg8 {
#define PG8_LAS __attribute__((address_space(3)))
typedef unsigned short bf16_t;
typedef short bf16x8 __attribute__((ext_vector_type(8)));
typedef float f32x4 __attribute__((ext_vector_type(4)));
typedef unsigned u32x4 __attribute__((ext_vector_type(4)));
constexpr int BM = 256, BK = 64, HALF = 128, HTB = HALF * BK * 2  , STAGE_BYTES = 8 * HTB, NXCD = 8, WGM = 8;

__host__ __device__ __forceinline__ int lds_byte(int r, int c) { const int st = (r >> 4) * 2 + (c >> 5), rr = r & 15, cc = c & 31, ob = rr * 64 + cc * 2; return st * 1024 + (ob ^ (((ob >> 9) & 1) << 5)); }
__host__ __device__ __forceinline__ void stage_rc(int b, int& R, int& C) { const int st = b / 1024, sb = b % 1024, swz = sb ^ (((sb >> 9) & 1) << 5); R = (st >> 1) * 16 + swz / 64; C = (st & 1) * 32 + (swz % 64) / 2; }
__host__ __device__ __forceinline__ int perm32(int rho) { const int n = rho >> 4, i = rho & 15; return 8 * (i >> 2) + 4 * n + (i & 3); }

struct Unit { int pm, pn, ui; };
struct Gemm { const bf16_t* A; const bf16_t* Bt; int M, N, K; };

struct StaticOrder {
    int nM, nN, nwg, G, c, wgm;
    __host__ __device__ void init(int M, int N, int G_, int c_, int wgm_ = WGM) { nM = M / BM; nN = N / BM; nwg = nM * nN; G = G_; c = c_; wgm = wgm_; }
    __host__ __device__ bool next(int i, Unit& u) const {
        const long L = (long)i * G + c; if (L >= nwg) return false;
        int wgid = (int)L; { const int q = nwg / NXCD, r = nwg % NXCD, xcd = wgid % NXCD, off = wgid / NXCD; wgid = (xcd < r ? xcd * (q + 1) : r * (q + 1) + (xcd - r) * q) + off; }
        const int nig = wgm * nN, gid = wgid / nig, fm = gid * wgm, gsz = (nM - fm) < wgm ? (nM - fm) : wgm;
        u.pm = fm + ((wgid % nig) % gsz); u.pn = (wgid % nig) / gsz; return true;
    }
    __device__ __forceinline__ void a_ready(const Unit&) const {}
    __device__ __forceinline__ void done(const Unit&) const {}
};

struct MaskOrder : StaticOrder { int mask; __host__ __device__ bool next(int i, Unit& u) const { const bool ok = StaticOrder::next(i, u); u.pm &= mask; return ok; } };
__device__ __forceinline__ unsigned cvt_pk_bf16(float lo, float hi) { unsigned r; asm volatile("v_cvt_pk_bf16_f32 %0, %1, %2" : "=v"(r) : "v"(lo), "v"(hi)); return r; }
__device__ __forceinline__ void store16_sc1(void* p, u32x4 v) { asm volatile("global_store_dwordx4 %0, %1, off sc1\n\ts_nop 1" :: "v"(p), "v"(v) : "memory"); }
__device__ __forceinline__ float bf_lo(unsigned w) { return __uint_as_float(w << 16); }
__device__ __forceinline__ float bf_hi(unsigned w) { return __uint_as_float(w & 0xffff0000u); }
__device__ __forceinline__ float fast_sigmoid(float x) { return __builtin_amdgcn_rcpf(1.0f + __expf(-x)); }
__device__ __forceinline__ f32x4 shfl_xor4(f32x4 v, int mask) { f32x4 r; r[0] = __shfl_xor(v[0], mask); r[1] = __shfl_xor(v[1], mask); r[2] = __shfl_xor(v[2], mask); r[3] = __shfl_xor(v[3], mask); return r; }

constexpr int GS_LDS_OFF = 131072;
constexpr int RS_LDS_OFF = 131072;
template <class Sched> __device__ __forceinline__ void stage_row_scales(PG8_LAS unsigned char* lds, const float* SS, const Sched& S, int tid) {
    PG8_LAS float* sl = (PG8_LAS float*)(lds + RS_LDS_OFF);
    Unit u;
    int prev_pm = -1; float val = 0.f;
    for (int i = 0; i < 12 && S.next(i, u); ++i) {
        if (tid < 256) {
            if (u.pm != prev_pm) { const f32x4* p = (const f32x4*)(SS + (size_t)(u.pm * BM + tid) * 32); float t = 0.f;
#pragma unroll
                for (int k = 0; k < 8; ++k) { const f32x4 a = p[k]; t += (a[0] + a[1]) + (a[2] + a[3]); }
                val = __builtin_amdgcn_rsqf(t * (1.0f / 2048.0f) + 1e-5f); }
            sl[i * 256 + tid] = val; }
        prev_pm = u.pm;
    }
    __syncthreads();
}
template <class Sched> __device__ __forceinline__ void stage_group_scales(PG8_LAS unsigned char* lds, const float* SSG, const Sched& S, int tid) {
    PG8_LAS float* gt = (PG8_LAS float*)(lds + GS_LDS_OFF);
    Unit u;
    for (int i = 0; i < 4 && S.next(i, u); ++i) {
        if (tid < 256) { const f32x4* p = (const f32x4*)(SSG + (size_t)(u.pm * BM + tid) * 64); float s[8]; f32x4 q[16];
#pragma unroll
            for (int g = 0; g < 16; ++g) q[g] = p[g];
            __builtin_amdgcn_sched_barrier(0);
#pragma unroll
            for (int g = 0; g < 8; ++g) { const f32x4 a = q[2 * g], c = q[2 * g + 1]; s[g] = __builtin_amdgcn_rsqf((((a[0] + a[1]) + (a[2] + a[3])) + ((c[0] + c[1]) + (c[2] + c[3]))) * (1.0f / 512.0f) + 1e-5f); }
#pragma unroll
            for (int g = 0; g < 7; ++g) gt[(i * 256 + tid) * 8 + g] = s[g] * __builtin_amdgcn_rcpf(s[g + 1]);
            gt[(i * 256 + tid) * 8 + 7] = s[7]; }
    }
    __syncthreads();
}
__device__ __forceinline__ void row_scales(PG8_LAS unsigned char* lds, const Unit& u, int wr, int fr, float (&s)[8]) {
    const PG8_LAS float* sl = (const PG8_LAS float*)(lds + RS_LDS_OFF) + u.ui * 256 + wr * 64 + fr;
#pragma unroll
    for (int i = 0; i < 8; ++i) s[i] = sl[(i >> 2) * HALF + (i & 3) * 16];
}


struct EpiSwiGLU {
    static constexpr bool PERM = true, AFTER_DRAIN = false;
    bf16_t* H; int ldc; PG8_LAS unsigned char* lds;
    __device__ __forceinline__ void operator()(const f32x4 (&acc)[2][2][4][2], const Unit& u, int wr, int wc, int fr, int fq) const {
        float rs[8]; row_scales(lds, u, wr, fr, rs);
#pragma unroll
        for (int ai = 0; ai < 2; ++ai)
#pragma unroll
            for (int m = 0; m < 4; ++m) {
                bf16_t* rowp = H + ((size_t)(u.pm * (ldc >> 6) + u.pn * 2 + (wc >> 1)) * BM + (wr * 64 + fr + ai * HALF + m * 16)) * 64 + (wc & 1) * 32 + 8 * fq;
                const float sc = rs[ai * 4 + m], sc2 = sc * sc, scl = -1.4426950408889634f * sc;
                typedef float f2 __attribute__((ext_vector_type(2)));
                const float isc = __builtin_amdgcn_rcpf(sc2); const f2 scl2 = {scl, scl}, isc2 = {isc, isc};
                f2 e[4], gu[4]; float h[8];
#pragma unroll
                for (int n = 0; n < 2; ++n)
#pragma unroll
                    for (int jp = 0; jp < 2; ++jp) { const f2 g = {acc[ai][0][m][n][2 * jp], acc[ai][0][m][n][2 * jp + 1]}, uu = {acc[ai][1][m][n][2 * jp], acc[ai][1][m][n][2 * jp + 1]};
                        const f2 t = g * scl2; e[2 * n + jp] = (f2){__builtin_amdgcn_exp2f(t.x), __builtin_amdgcn_exp2f(t.y)}; gu[2 * n + jp] = g * uu; }
#pragma unroll
                for (int k = 0; k < 4; ++k) { const f2 d = __builtin_elementwise_fma(e[k], isc2, isc2); e[k] = (f2){__builtin_amdgcn_rcpf(d.x), __builtin_amdgcn_rcpf(d.y)}; }
#pragma unroll
                for (int k = 0; k < 4; ++k) { const f2 hh = gu[k] * e[k]; h[2 * k] = hh.x; h[2 * k + 1] = hh.y; }
                u32x4 w; w.x = cvt_pk_bf16(h[0], h[1]); w.y = cvt_pk_bf16(h[2], h[3]); w.z = cvt_pk_bf16(h[4], h[5]); w.w = cvt_pk_bf16(h[6], h[7]);
                *(u32x4*)rowp = w; }
    }
};
struct EpiResid {
    static constexpr bool PERM = true, AFTER_DRAIN = false;
    const bf16_t* res; bf16_t* out; float* SS; int ldc; int half;
    PG8_LAS unsigned char* lds;
    __device__ __forceinline__ void load_half(u32x4 (&r)[4][2], int ai, const bf16_t* rb) const {
#pragma unroll
        for (int m = 0; m < 4; ++m)
#pragma unroll
            for (int bj = 0; bj < 2; ++bj) r[m][bj] = *(const u32x4*)(rb + bj * 32768 + ai * 8192 + m * 1024);
    }
    __device__ __forceinline__ void store_half(const u32x4 (&r)[4][2], const f32x4 (&acc)[2][2][4][2], int ai, bf16_t* ob, int row0, int pn, int wc, int fq, float scale, int uui) const {
#pragma unroll
        for (int m = 0; m < 4; ++m) { const int row = row0 + ai * HALF + m * 16; float q = 0.f;
            if (half == 2) scale = ((const PG8_LAS float*)(lds + GS_LDS_OFF))[(size_t)((uui * 256 + (row & 255)) * 8 + 7)];
#pragma unroll
            for (int bj = 0; bj < 2; ++bj) { const u32x4 w0 = r[m][bj]; const f32x4 a0 = acc[ai][bj][m][0], a1 = acc[ai][bj][m][1];
                const float x0 = bf_lo(w0.x) + a0[0] * scale, x1 = bf_hi(w0.x) + a0[1] * scale, x2 = bf_lo(w0.y) + a0[2] * scale, x3 = bf_hi(w0.y) + a0[3] * scale;
                const float x4 = bf_lo(w0.z) + a1[0] * scale, x5 = bf_hi(w0.z) + a1[1] * scale, x6 = bf_lo(w0.w) + a1[2] * scale, x7 = bf_hi(w0.w) + a1[3] * scale;
                u32x4 w; w.x = cvt_pk_bf16(x0, x1); w.y = cvt_pk_bf16(x2, x3); w.z = cvt_pk_bf16(x4, x5); w.w = cvt_pk_bf16(x6, x7);
                *(u32x4*)(ob + bj * 32768 + ai * 8192 + m * 1024) = w;
                q += ((x0 * x0 + x1 * x1) + (x2 * x2 + x3 * x3)) + ((x4 * x4 + x5 * x5) + (x6 * x6 + x7 * x7)); }
            q += __shfl_xor(q, 16); q += __shfl_xor(q, 32);
            if (fq == 0) SS[(size_t)row * 32 + pn * 4 + wc] = q; }
    }
    __device__ __forceinline__ void operator()(const f32x4 (&acc)[2][2][4][2], const Unit& u, int wr, int wc, int fr, int fq) const {
        const int row0 = u.pm * BM + wr * 64 + fr; const float scale = half ? 0.5f : 1.0f;
        const size_t base = ((size_t)(u.pm * (ldc >> 6) + u.pn * 4 + (wc >> 1)) * BM + (wr * 64 + fr)) * 64 + (wc & 1) * 32 + 8 * fq;
        u32x4 ra[4][2], rb[4][2];
        load_half(ra, 0, res + base); load_half(rb, 1, res + base);
        store_half(ra, acc, 0, out + base, row0, u.pn, wc, fq, scale, u.ui);
        store_half(rb, acc, 1, out + base, row0, u.pn, wc, fq, scale, u.ui);
    }
};
struct EpiEvenIn {
    static constexpr bool PERM = true, AFTER_DRAIN = false;
    bf16_t *Q, *K, *V, *U; const float* rot; PG8_LAS unsigned char* lds;
    __device__ __forceinline__ void operator()(const f32x4 (&acc)[2][2][4][2], const Unit& u, int wr, int wc, int fr, int fq) const {
        const int pn = u.pn; bf16_t* dst; int ldc, colt; bool rotary = false; float sc = 1.f;
        if (pn < 4) { dst = Q; ldc = 1024; colt = pn * 256; rotary = true; sc = 0.125f; }
        else if (pn == 4) { dst = K; ldc = 256; colt = 0; rotary = true; }
        else if (pn == 5) { dst = V; ldc = 256; colt = 0; }
        else { dst = U; ldc = 1024; colt = (pn - 6) * 256; }
        const int row0 = u.pm * BM + wr * 64 + fr, col0 = colt + wc * 32 + 8 * fq;
        const bool rotw = rotary && ((wc & 1) == 0);
        float rs[8]; row_scales(lds, u, wr, fr, rs);
#pragma unroll
        for (int aim = 0; aim < 4; ++aim) { const int ai = aim >> 1;
            f32x4 cs[4][4];
            if (rotw) {
#pragma unroll
                for (int m = 2 * (aim & 1); m < 2 * (aim & 1) + 2; ++m) { const f32x4* rp = (const f32x4*)(rot + (size_t)(row0 + ai * HALF + m * 16) * 16); cs[m][0] = rp[0]; cs[m][1] = rp[1]; cs[m][2] = rp[2]; cs[m][3] = rp[3]; }
            }
#pragma unroll
            for (int m = 2 * (aim & 1); m < 2 * (aim & 1) + 2; ++m) { const int row = row0 + ai * HALF + m * 16; bf16_t* rowp = dst + (size_t)row * ldc + col0;
#pragma unroll
                for (int bj = 0; bj < 2; ++bj) { f32x4 v0 = acc[ai][bj][m][0] * rs[ai * 4 + m], v1 = acc[ai][bj][m][1] * rs[ai * 4 + m];
                    if (rotw) { const f32x4 p0 = shfl_xor4(v0, 16), p1 = shfl_xor4(v1, 16);
                        if (fq == 0) { v0 = v0 * cs[m][0] - p0 * cs[m][2]; v1 = v1 * cs[m][1] - p1 * cs[m][3]; }
                        else if (fq == 1) { v0 = v0 * cs[m][0] + p0 * cs[m][2]; v1 = v1 * cs[m][1] + p1 * cs[m][3]; } }
                    v0 = v0 * sc; v1 = v1 * sc;
                    u32x4 w; w.x = cvt_pk_bf16(v0[0], v0[1]); w.y = cvt_pk_bf16(v0[2], v0[3]); w.z = cvt_pk_bf16(v1[0], v1[1]); w.w = cvt_pk_bf16(v1[2], v1[3]);
                    *(u32x4*)(rowp + bj * HALF) = w; } }
        }
    }
};
struct EpiGLU {
    static constexpr bool PERM = true, AFTER_DRAIN = false;
    const bf16_t* G; const float* bias; bf16_t* CAT;
    __device__ __forceinline__ void operator()(const f32x4 (&acc)[2][2][4][2], const Unit& u, int wr, int wc, int fr, int fq) const {
        const int row0 = u.pm * BM + wr * 64 + fr, col0 = u.pn * BM + wc * 32 + 8 * fq;
        f32x4 bv[2][2];
#pragma unroll
        for (int bj = 0; bj < 2; ++bj) { bv[bj][0] = *(const f32x4*)(bias + col0 + bj * HALF); bv[bj][1] = *(const f32x4*)(bias + col0 + bj * HALF + 4); }
#pragma unroll
        for (int ai = 0; ai < 2; ++ai) {
            u32x4 gw[4][2];
#pragma unroll
            for (int m = 0; m < 4; ++m)
#pragma unroll
                for (int bj = 0; bj < 2; ++bj) gw[m][bj] = *(const u32x4*)(G + (size_t)(row0 + ai * HALF + m * 16) * 1024 + col0 + bj * HALF);
#pragma unroll
            for (int m = 0; m < 4; ++m) { const int row = row0 + ai * HALF + m * 16;
#pragma unroll
                for (int bj = 0; bj < 2; ++bj) { const int col = col0 + bj * HALF; const u32x4 g4 = gw[m][bj];
                    const f32x4 a0 = acc[ai][bj][m][0] + bv[bj][0], a1 = acc[ai][bj][m][1] + bv[bj][1];
                    float o[8];
                    o[0] = bf_lo(g4.x) * fast_sigmoid(a0[0]); o[1] = bf_hi(g4.x) * fast_sigmoid(a0[1]); o[2] = bf_lo(g4.y) * fast_sigmoid(a0[2]); o[3] = bf_hi(g4.y) * fast_sigmoid(a0[3]);
                    o[4] = bf_lo(g4.z) * fast_sigmoid(a1[0]); o[5] = bf_hi(g4.z) * fast_sigmoid(a1[1]); o[6] = bf_lo(g4.w) * fast_sigmoid(a1[2]); o[7] = bf_hi(g4.w) * fast_sigmoid(a1[3]);
                    u32x4 w; w.x = cvt_pk_bf16(o[0], o[1]); w.y = cvt_pk_bf16(o[2], o[3]); w.z = cvt_pk_bf16(o[4], o[5]); w.w = cvt_pk_bf16(o[6], o[7]);
                    *(u32x4*)(CAT + (size_t)row * 2048 + 1024 + col) = w; } }
        }
    }
};
struct EpiOddIn {
    static constexpr bool PERM = true, AFTER_DRAIN = false;
    bf16_t *Z, *XBC; float* DT; PG8_LAS unsigned char* lds;
    __device__ __forceinline__ void operator()(const f32x4 (&acc)[2][2][4][2], const Unit& u, int wr, int wc, int fr, int fq) const {
        const int pn = u.pn; const int row0 = u.pm * BM + wr * 64 + fr;
        float rs[8]; row_scales(lds, u, wr, fr, rs);
        if (pn == 40) {
            if (wc < 2) {
#pragma unroll
                for (int ai = 0; ai < 2; ++ai)
#pragma unroll
                    for (int m = 0; m < 4; ++m) { float* rowp = DT + (size_t)(row0 + ai * HALF + m * 16) * 64 + wc * 32 + 8 * fq;
                        *(f32x4*)rowp = acc[ai][0][m][0] * rs[ai * 4 + m]; *(f32x4*)(rowp + 4) = acc[ai][0][m][1] * rs[ai * 4 + m]; }
            }
            return;
        }
        bf16_t* dst; int ldc, colt;
        if (pn < 16) { dst = Z; ldc = 4096; colt = pn * 256; } else { dst = XBC; ldc = 6144; colt = (pn - 16) * 256; }
        const int col0 = colt + wc * 32 + 8 * fq;
#pragma unroll
        for (int ai = 0; ai < 2; ++ai)
#pragma unroll
            for (int m = 0; m < 4; ++m) { bf16_t* rowp = dst + (size_t)(row0 + ai * HALF + m * 16) * ldc + col0;
#pragma unroll
                for (int bj = 0; bj < 2; ++bj) { const f32x4 v0 = acc[ai][bj][m][0] * rs[ai * 4 + m], v1 = acc[ai][bj][m][1] * rs[ai * 4 + m];
                    u32x4 w; w.x = cvt_pk_bf16(v0[0], v0[1]); w.y = cvt_pk_bf16(v0[2], v0[3]); w.z = cvt_pk_bf16(v1[0], v1[1]); w.w = cvt_pk_bf16(v1[2], v1[3]);
                    *(u32x4*)(rowp + bj * HALF) = w; } }
    }
};

template <class Epi, class Sched, bool ALIGN_EPI = false, bool SP2 = false, bool TILED_A = false, bool TILED_B = false, bool GSCALE = false>
__device__ __forceinline__ void gemm_phase(PG8_LAS unsigned char* lds, const Gemm g, const Sched& S, const Epi& E, int tid_in) {
    int tid = tid_in; const int wid = __builtin_amdgcn_readfirstlane(tid >> 6), lane = tid & 63, wr = wid >> 2, wc = wid & 3, fr = lane & 15, fq = lane >> 4;
    const int K = g.K, nt = K / BK;
    unsigned voffA[2], voffB[2];
#pragma unroll
    for (int i = 0; i < 2; ++i) { int R, C; stage_rc(tid * 16 + i * 8192, R, C); const int Rb = Epi::PERM ? ((R & ~31) + perm32(R & 31)) : R;
        voffA[i] = (unsigned)(R * (TILED_A ? BK : K) + C) * 2u; voffB[i] = (unsigned)(Rb * (TILED_B ? BK : K) + C) * 2u; }
    const size_t kstepA = TILED_A ? (size_t)(BM * BK * 2) : (size_t)(BK * 2), kstepB = TILED_B ? (size_t)(BM * BK * 2) : (size_t)(BK * 2);
    const size_t hstepA = TILED_A ? (size_t)(HALF * BK * 2) : (size_t)HALF * K * 2, hstepB = TILED_B ? (size_t)(HALF * BK * 2) : (size_t)HALF * K * 2;
    const size_t tstepA = TILED_A ? (size_t)nt * (BM * BK * 2) : 2 * hstepA, tstepB = TILED_B ? (size_t)nt * (BM * BK * 2) : 2 * hstepB;
    const unsigned ldsw = (unsigned)wid * 1024u;
    const int aoff = lds_byte(wr * 64 + fr, fq * 8), boff = lds_byte(wc * 32 + fr, fq * 8);
#define PG8_SA(b, h) (((b) * 2 + (h)) * HTB)
#define PG8_SB(b, h) ((4 + (b) * 2 + (h)) * HTB)
#define PG8_STAGE(bufoff, gbase, voff) do { _Pragma("unroll") for (int _i = 0; _i < 2; ++_i) \
        __builtin_amdgcn_global_load_lds((const unsigned*)((const char*)(gbase) + (voff)[_i]), (PG8_LAS unsigned*)(lds + (bufoff) + ldsw + _i * 8192), 16, 0, 0); } while (0)
#define PG8_LDA(dst, b, h) do { _Pragma("unroll") for (int m = 0; m < 4; ++m) _Pragma("unroll") for (int k = 0; k < 2; ++k) dst[m][k] = *(const PG8_LAS bf16x8*)(lds + PG8_SA(b, h) + aoff + m * 2048 + k * 1024); } while (0)
#define PG8_LDB(dst, b, h) do { _Pragma("unroll") for (int n = 0; n < 2; ++n) _Pragma("unroll") for (int k = 0; k < 2; ++k) dst[n][k] = *(const PG8_LAS bf16x8*)(lds + PG8_SB(b, h) + boff + n * 2048 + k * 1024); } while (0)
#define PG8_MMA(ai, bj, At, Bt) do { __builtin_amdgcn_s_setprio(1); _Pragma("unroll") for (int m = 0; m < 4; ++m) _Pragma("unroll") for (int n = 0; n < 2; ++n) _Pragma("unroll") for (int k = 0; k < 2; ++k) \
        acc[ai][bj][m][n] = __builtin_amdgcn_mfma_f32_16x16x32_bf16(Bt[n][k], At[m][k], acc[ai][bj][m][n], 0, 0, 0); __builtin_amdgcn_s_setprio(0); } while (0)
#define PG8_WAIT_V(n) asm volatile("s_waitcnt vmcnt(" #n ")" ::: "memory")
#define PG8_WAIT_L(n) asm volatile("s_waitcnt lgkmcnt(" #n ")" ::: "memory")
#define PG8_BAR __builtin_amdgcn_s_barrier()
#define PG8_SCHED __builtin_amdgcn_sched_barrier(0)
    Unit cur, nxt; int ui = 0;
    if (!S.next(0, cur)) return;
    cur.ui = 0;
    f32x4 acc[2][2][4][2];
    typedef unsigned long pg8_u64x2 __attribute__((ext_vector_type(2)));
#define PG8_ZERO_ACC() do { unsigned long z64 = 0ul; asm volatile("" : "+v"(z64));     \
        _Pragma("unroll") for (int a = 0; a < 2; ++a) _Pragma("unroll") for (int b = 0; b < 2; ++b) _Pragma("unroll") for (int m = 0; m < 4; ++m) _Pragma("unroll") for (int n = 0; n < 2; ++n) \
            acc[a][b][m][n] = __builtin_bit_cast(f32x4, (pg8_u64x2){z64, z64}); } while (0)
    PG8_ZERO_ACC();
    bf16x8 At[4][2], B0[2][2], B1[2][2];
    const char* cA = (const char*)g.A + (size_t)cur.pm * tstepA; const char* cB = (const char*)g.Bt + (size_t)cur.pn * tstepB;
    S.a_ready(cur);
    if constexpr (SP2) {
        PG8_STAGE(PG8_SB(0, 0), cB, voffB); PG8_STAGE(PG8_SB(0, 1), cB + hstepB, voffB); PG8_STAGE(PG8_SA(0, 0), cA, voffA); PG8_STAGE(PG8_SA(0, 1), cA + hstepA, voffA);
        if (wr == 1) PG8_BAR;
        PG8_WAIT_V(2); PG8_BAR;
        PG8_STAGE(PG8_SB(1, 0), cB + kstepB, voffB); PG8_STAGE(PG8_SA(1, 0), cA + kstepA, voffA); PG8_STAGE(PG8_SB(1, 1), cB + hstepB + kstepB, voffB);
        PG8_WAIT_V(6); PG8_BAR;
    } else {
        PG8_STAGE(PG8_SB(0, 0), cB, voffB); PG8_STAGE(PG8_SA(0, 0), cA, voffA); PG8_STAGE(PG8_SB(0, 1), cB + hstepB, voffB); PG8_STAGE(PG8_SA(0, 1), cA + hstepA, voffA);
        if (wr == 1) PG8_BAR;
        PG8_WAIT_V(4); PG8_BAR;
        PG8_STAGE(PG8_SB(1, 0), cB + kstepB, voffB); PG8_STAGE(PG8_SA(1, 0), cA + kstepA, voffA); PG8_STAGE(PG8_SB(1, 1), cB + hstepB + kstepB, voffB);
        PG8_WAIT_V(6); PG8_BAR;
    }
    for (;;) {
        const bool has_next = S.next(ui + 1, nxt); nxt.ui = ui + 1;
        const char* nA = has_next ? (const char*)g.A + (size_t)nxt.pm * tstepA : cA; const char* nB = has_next ? (const char*)g.Bt + (size_t)nxt.pn * tstepB : cB;
        for (int t = 0; t < nt; t += 2) {
            const bool last = (t == nt - 2);
            const char* a1 = cA + (size_t)(t + 1) * kstepA;
            const char* a2 = last ? nA : cA + (size_t)(t + 2) * kstepA; const char* b2 = last ? nB : cB + (size_t)(t + 2) * kstepB;
            const char* a3 = a2 + kstepA; const char* b3 = b2 + kstepB;
            if (last && has_next) S.a_ready(nxt);
            if constexpr (GSCALE) { int tq = t; asm volatile("" : "+s"(tq));
              if (tq > 0 && (tq & 7) == 0) {
                const PG8_LAS float* gt = (const PG8_LAS float*)(lds + GS_LDS_OFF) + (size_t)((cur.ui * 256 + wr * 64 + fr) * 8 + (tq >> 3) - 1);
#pragma unroll
                for (int a = 0; a < 2; ++a)
#pragma unroll
                    for (int m = 0; m < 4; ++m) { const float rr = gt[(a * HALF + m * 16) * 8];
#pragma unroll
                        for (int bq = 0; bq < 2; ++bq)
#pragma unroll
                            for (int n = 0; n < 2; ++n) acc[a][bq][m][n] = acc[a][bq][m][n] * rr; }
                PG8_SCHED; } }
            if constexpr (SP2) {
            PG8_LDB(B0, 0, 0); PG8_LDB(B1, 0, 1); PG8_SCHED; PG8_LDA(At, 0, 0); PG8_STAGE(PG8_SA(1, 1), a1 + hstepA, voffA);
            PG8_WAIT_V(8); PG8_WAIT_L(0); PG8_BAR; PG8_MMA(0, 0, At, B0); PG8_MMA(0, 1, At, B1); PG8_BAR; PG8_SCHED;
            PG8_LDA(At, 0, 1); PG8_STAGE(PG8_SB(0, 0), b2, voffB); PG8_STAGE(PG8_SB(0, 1), b2 + hstepB, voffB); PG8_STAGE(PG8_SA(0, 0), a2, voffA);
            PG8_WAIT_V(8); PG8_WAIT_L(0); PG8_BAR; PG8_MMA(1, 0, At, B0); PG8_MMA(1, 1, At, B1); PG8_BAR; PG8_SCHED;
            PG8_LDB(B0, 1, 0); PG8_LDB(B1, 1, 1); PG8_SCHED; PG8_LDA(At, 1, 0); PG8_STAGE(PG8_SA(0, 1), a2 + hstepA, voffA);
            PG8_WAIT_V(8); PG8_WAIT_L(0); PG8_BAR; PG8_MMA(0, 0, At, B0); PG8_MMA(0, 1, At, B1); PG8_BAR; PG8_SCHED;
            PG8_LDA(At, 1, 1); PG8_STAGE(PG8_SB(1, 0), b3, voffB); PG8_STAGE(PG8_SB(1, 1), b3 + hstepB, voffB); PG8_STAGE(PG8_SA(1, 0), a3, voffA);
            PG8_WAIT_V(8); PG8_WAIT_L(0); PG8_BAR; PG8_MMA(1, 0, At, B0); PG8_MMA(1, 1, At, B1); PG8_BAR; PG8_SCHED;
            } else {
            PG8_LDB(B0, 0, 0); PG8_SCHED; PG8_LDA(At, 0, 0); PG8_STAGE(PG8_SA(1, 1), a1 + hstepA, voffA);
            PG8_WAIT_L(8); PG8_BAR; PG8_WAIT_L(0); PG8_MMA(0, 0, At, B0); PG8_BAR; PG8_SCHED;
            PG8_LDB(B1, 0, 1); PG8_STAGE(PG8_SB(0, 0), b2, voffB);
            PG8_BAR; PG8_WAIT_L(0); PG8_MMA(0, 1, At, B1); PG8_BAR;
            PG8_LDA(At, 0, 1); PG8_STAGE(PG8_SA(0, 0), a2, voffA);
            PG8_BAR; PG8_WAIT_L(0); PG8_MMA(1, 0, At, B0); PG8_BAR; PG8_SCHED;
            PG8_STAGE(PG8_SB(0, 1), b2 + hstepB, voffB);
            PG8_WAIT_V(6); PG8_BAR; PG8_MMA(1, 1, At, B1); PG8_BAR;
            PG8_LDB(B0, 1, 0); PG8_SCHED; PG8_LDA(At, 1, 0); PG8_STAGE(PG8_SA(0, 1), a2 + hstepA, voffA);
            PG8_WAIT_L(8); PG8_BAR; PG8_WAIT_L(0); PG8_MMA(0, 0, At, B0); PG8_BAR; PG8_SCHED;
            PG8_LDB(B1, 1, 1); PG8_STAGE(PG8_SB(1, 0), b3, voffB);
            PG8_BAR; PG8_WAIT_L(0); PG8_MMA(0, 1, At, B1); PG8_BAR;
            PG8_LDA(At, 1, 1); PG8_STAGE(PG8_SA(1, 0), a3, voffA);
            PG8_BAR; PG8_WAIT_L(0); PG8_MMA(1, 0, At, B0); PG8_BAR; PG8_SCHED;
            PG8_STAGE(PG8_SB(1, 1), b3 + hstepB, voffB);
            PG8_WAIT_V(6); PG8_BAR; PG8_MMA(1, 1, At, B1); PG8_BAR;
            }
        }
        if constexpr (ALIGN_EPI) { if (wr == 0) PG8_BAR; }
        if constexpr (!Epi::AFTER_DRAIN) { int fr_e = fr, fq_e = fq; asm volatile("" : "+v"(fr_e), "+v"(fq_e));
            E(acc, cur, wr, wc, fr_e, fq_e); S.done(cur); }
        if (!has_next) break;
        PG8_ZERO_ACC();
        cur = nxt; cA = nA; cB = nB; ++ui;
        if constexpr (ALIGN_EPI) { if (wr == 1) PG8_BAR; }
    }
    PG8_WAIT_V(0);
    if constexpr (!ALIGN_EPI) { if (wr == 0) PG8_BAR; }
    PG8_BAR;
    if constexpr (Epi::AFTER_DRAIN) { E.fused(acc, cur, wr, wc, fr, fq, lds, wid, lane); S.done(cur); }
#undef PG8_SA
#undef PG8_SB
#undef PG8_STAGE
#undef PG8_LDA
#undef PG8_LDB
#undef PG8_MMA
#undef PG8_ZERO_ACC
#undef PG8_WAIT_V
#undef PG8_WAIT_L
#undef PG8_BAR
#undef PG8_SCHED
}
}

#define GAS __attribute__((address_space(1)))
#define LAS __attribute__((address_space(3)))
#define CAS __attribute__((address_space(4)))
typedef unsigned short bf16;
typedef unsigned v4u __attribute__((ext_vector_type(4)));
typedef unsigned v2u __attribute__((ext_vector_type(2)));
typedef float f32x4 __attribute__((ext_vector_type(4)));
typedef float f32x2v __attribute__((ext_vector_type(2)));
typedef __bf16 bf16x2v __attribute__((ext_vector_type(2)));
__device__ __forceinline__ unsigned pkbf(float a, float b) { const f32x2v v = {a, b}; const bf16x2v r = __builtin_convertvector(v, bf16x2v); return __builtin_bit_cast(unsigned, r); }
#define LDS_WAIT() asm volatile("s_waitcnt lgkmcnt(0)" ::: "memory")
#define LDS_BARRIER() do { asm volatile("s_waitcnt lgkmcnt(0)" ::: "memory"); __builtin_amdgcn_s_barrier(); asm volatile("" ::: "memory"); } while (0)
__device__ __forceinline__ unsigned f2bf(float f) { unsigned u = __builtin_bit_cast(unsigned, f); return (u + 0x7fffu + ((u >> 16) & 1u)) >> 16; }
__device__ __forceinline__ unsigned pk2(float lo, float hi) { return f2bf(lo) | (f2bf(hi) << 16); }
__device__ __forceinline__ float bf2f(unsigned short b) { return __uint_as_float(((unsigned)b) << 16); }
__device__ __forceinline__ float blo(unsigned w) { return __uint_as_float(w << 16); }
__device__ __forceinline__ float bhi(unsigned w) { return __uint_as_float(w & 0xffff0000u); }
__device__ __forceinline__ float wave_sum(float v) {
#pragma unroll
    for (int o = 1; o < 64; o <<= 1) v += __shfl_xor(v, o);
    return v;
}
__device__ __forceinline__ float wave_max(float v) {
#pragma unroll
    for (int o = 1; o < 64; o <<= 1) v = fmaxf(v, __shfl_xor(v, o));
    return v;
}
__device__ __forceinline__ float sigmoidf_(float x) { return __builtin_amdgcn_rcpf(1.0f + __expf(-x)); }
__device__ __forceinline__ float fsig(float x) { return __builtin_amdgcn_rcpf(1.0f + __expf(-x)); }
__device__ __forceinline__ float siluf_(float x) { return x * sigmoidf_(x); }
__device__ __forceinline__ float gelu_tanh(float x) { const float z = 0.7978845608028654f * (x + 0.044715f * x * x * x); const float t = 1.0f - 2.0f * __builtin_amdgcn_rcpf(__expf(2.0f * z) + 1.0f); return 0.5f * x * (1.0f + t); }
__device__ __forceinline__ float softplusf_(float x) { const float e = __expf(x); return x > 20.f ? x : (e < 1e-3f ? e * (1.0f - 0.5f * e) : __logf(1.0f + e)); }

#define XB_TMO      128
#define XB_XCNT(j)  (256  + 64 * (j))
#define XB_XSUB(j)  (1280 + 64 * (j))
#define XB_XGEN(j)  (2304 + 64 * (j))
#define XB_TOP      3328
#define XB_TOPGEN   3392
#define XCD_BAR_WORDS 3456
#define XB_SPIN_CAP (1u << 18)

__device__ __forceinline__ unsigned xb_ld(unsigned* p)              { return __hip_atomic_load(p, __ATOMIC_RELAXED, __HIP_MEMORY_SCOPE_AGENT); }
__device__ __forceinline__ unsigned xb_add(unsigned* p, unsigned v) { return __hip_atomic_fetch_add(p, v, __ATOMIC_RELAXED, __HIP_MEMORY_SCOPE_AGENT); }
__device__ __forceinline__ unsigned xb_xcc_id() { return (unsigned)__builtin_amdgcn_s_getreg((3 << 11) | 20) & 0xFu; }
#define XB_SPIN(cond, bar) do { unsigned _sp = 0; while (cond) { __builtin_amdgcn_s_sleep(1); \
    if ((++_sp & 255u) == 0u) { if (xb_ld(&(bar)[XB_TMO])) break; if (_sp > XB_SPIN_CAP) { atomicAdd(&(bar)[XB_TMO], 1u); break; } } } } while (0)

struct XcdBarrier {
    unsigned* bar; unsigned x;
    volatile LAS unsigned* st; bool lead;
};

__device__ __forceinline__ XcdBarrier xcd_barrier_post(unsigned* bar, volatile LAS unsigned* st) {
    XcdBarrier b; b.bar = bar; b.x = xb_xcc_id(); b.st = st;
    if (threadIdx.x == 0) (void)xb_add(&bar[XB_XCNT(b.x)], 1u);
    return b;
}
__device__ __forceinline__ void xcd_barrier_complete(unsigned* bar, unsigned x, unsigned& nloc, unsigned& nx) {
    const unsigned G = gridDim.x * gridDim.y * gridDim.z;
    unsigned sum, cnt, mine, sp = 0u;
    for (;;) {
        sum = 0u; cnt = 0u; mine = 0u;
#pragma unroll
        for (unsigned j = 0; j < 16; ++j) { const unsigned c = xb_ld(&bar[XB_XCNT(j)]); sum += c; cnt += (c > 0u) ? 1u : 0u; mine = (j == x) ? c : mine; }
        if (sum == G) break;
        __builtin_amdgcn_s_sleep(1);
        if ((++sp & 255u) == 0u) { if (xb_ld(&bar[XB_TMO])) break; if (sp > XB_SPIN_CAP) { atomicAdd(&bar[XB_TMO], 1u); break; } }
    }
    nloc = mine > 0u ? mine : 1u; nx = cnt > 0u ? cnt : 1u;
}

__device__ __forceinline__ void xcd_barrier(const XcdBarrier& b) {
    asm volatile("s_waitcnt vmcnt(0)" ::: "memory");
    __syncthreads();
    if (b.lead) {
        unsigned* bar = b.bar;
        __builtin_amdgcn_s_waitcnt(0);
        unsigned nloc = b.st[0], nx = b.st[1];
        if (nloc == 0u) { xcd_barrier_complete(bar, b.x, nloc, nx); b.st[0] = nloc; b.st[1] = nx; }
        const unsigned old = xb_add(&bar[XB_XSUB(b.x)], 1u);
        const unsigned gen = old / nloc;
        if (old + 1u == (gen + 1u) * nloc) {
            __builtin_amdgcn_fence(__ATOMIC_RELEASE, "agent");
            asm volatile("s_waitcnt vmcnt(0)" ::: "memory");
            const unsigned og = xb_add(&bar[XB_TOP], 1u);
            const unsigned tg = og / nx;
            if (og + 1u == (tg + 1u) * nx) xb_add(&bar[XB_TOPGEN], 1u);
            else XB_SPIN(xb_ld(&bar[XB_TOPGEN]) == tg, bar);
            __builtin_amdgcn_fence(__ATOMIC_ACQUIRE, "agent");
            xb_add(&bar[XB_XGEN(b.x)], 1u);
            asm volatile("s_waitcnt vmcnt(0)" ::: "memory");
        } else {
            XB_SPIN(xb_ld(&bar[XB_XGEN(b.x)]) == gen, bar);
            __builtin_amdgcn_fence(__ATOMIC_ACQUIRE, "agent");
            asm volatile("s_waitcnt vmcnt(0)" ::: "memory");
        }
    }
    __syncthreads();
}

constexpr size_t MiB = 1u << 20;
constexpr size_t WS_CTL = 0, CTL_ZERO_BYTES = 64 * 1024;
constexpr size_t WS_ROT = 1 * MiB;
constexpr size_t WS_X = 2 * MiB;
constexpr size_t WS_XN = 130 * MiB;
constexpr size_t WS_R = 194 * MiB;
constexpr size_t R_H = 0;
constexpr size_t R_Q = 0, R_K = 32 * MiB, R_V = 40 * MiB, R_U = 48 * MiB, R_G = 80 * MiB, R_CAT = 112 * MiB;
constexpr size_t R_Z = 0, R_XBC = 128 * MiB, R_XBCC = 320 * MiB, R_DT = 512 * MiB, R_YG = 128 * MiB, R_YN = 0;
constexpr size_t WS_W = 710 * MiB;
constexpr size_t W_GU0 = 0, W_D0 = 44 * MiB, W_GU1 = 66 * MiB, W_D1 = 110 * MiB, W_MIX = 132 * MiB;
constexpr size_t W_EIN = W_MIX, W_EGLU = W_MIX + 10 * MiB, W_EOUT = W_MIX + 12 * MiB;
constexpr size_t W_OIN = W_MIX, W_OOUT = W_MIX + 41 * MiB;
constexpr size_t WS_SS = 899 * MiB;
constexpr size_t WS_SSG = 901 * MiB;
constexpr size_t WS_END = 905 * MiB;
constexpr int CW_BAR = 1024;
static_assert((CW_BAR + XCD_BAR_WORDS) * 4 <= (int)CTL_ZERO_BYTES, "barrier words inside the memset region");

constexpr int RING_BYTES = 131072;
constexpr int MISC_OFF = 163840 - 64;
constexpr int LDS_BYTES = 163840;

struct Params { const void* in[33]; float* out; unsigned char* ws; int lo, hi; };

enum { I_X = 0, I_POS, I_NFFN1, I_F1G, I_F1U, I_F1D, I_NMIX, I_NFFN2, I_F2G, I_F2U, I_F2D, I_EWIN, I_SINK, I_ARE, I_AIM, I_LOGDT, I_BRE, I_BIM, I_CRE, I_CIM, I_S5D, I_WGLU, I_BGLU, I_EWOUT,
       I_MWIN, I_CONVW, I_CONVB, I_DTB, I_ALOG, I_MD, I_MNORM, I_MWOUT, I_FNORM };

__device__ __forceinline__ void convert_matrix(const float* W, int K, int N, bf16* WT, int grp, int gstride, int off, LAS float* scr, int gw, int NGW, int lane) {
    const int nblk = N / 32, nitems = (K / 64) * nblk;
    for (int item = gw; item < nitems; item += NGW) {
        const int kb = item / nblk, nb = item % nblk, k0 = 64 * kb, n0 = 32 * nb;
#pragma unroll 8
        for (int i = 0; i < 32; ++i) { const int kk = 2 * i + (lane >> 5); scr[kk * 33 + (lane & 31)] = W[(size_t)(k0 + kk) * N + n0 + (lane & 31)]; }
        LDS_WAIT(); asm volatile("" ::: "memory");
        const int c = lane & 7;
#pragma unroll
        for (int j = 0; j < 4; ++j) { const int n = (lane >> 3) + 8 * j; const LAS float* s = scr + (8 * c) * 33 + n;
            v4u o; o.x = pk2(s[0 * 33], s[1 * 33]); o.y = pk2(s[2 * 33], s[3 * 33]); o.z = pk2(s[4 * 33], s[5 * 33]); o.w = pk2(s[6 * 33], s[7 * 33]);
            const int nn = n0 + n; const int row = (nn / grp) * gstride + (nn % grp) + off;
            *(v4u*)(WT + (size_t)row * K + k0 + 8 * c) = o; }
        LDS_WAIT(); asm volatile("" ::: "memory");
    }
}
__device__ __forceinline__ void ph_rmsnorm_bf16(const float* src, const float* g, bf16* dst, int gw, int NGW, int lane) {
    for (int m = gw; m < M_TOK; m += NGW) {
        const f32x4* xr = (const f32x4*)(src + (size_t)m * D_MODEL) + lane;
        f32x4 v[8]; float s = 0.f;
#pragma unroll
        for (int j = 0; j < 8; ++j) { v[j] = xr[64 * j]; s += (v[j].x * v[j].x + v[j].y * v[j].y) + (v[j].z * v[j].z + v[j].w * v[j].w); }
        const float r = 1.0f / sqrtf(wave_sum(s) * (1.0f / D_MODEL) + NORM_EPS);
        v2u* o8 = (v2u*)(dst + (size_t)m * D_MODEL) + lane;
#pragma unroll
        for (int j = 0; j < 8; ++j) { const f32x4 gg = ((const f32x4*)g)[lane + 64 * j]; v2u w; w.x = pk2(v[j].x * r * gg.x, v[j].y * r * gg.y); w.y = pk2(v[j].z * r * gg.z, v[j].w * r * gg.w); o8[64 * j] = w; }
    }
}
__device__ __forceinline__ size_t xb_off(int row, int col) { return ((size_t)((row >> 8) * (D_MODEL / 64) + (col >> 6)) * 256 + (row & 255)) * 64 + (col & 63); }
__device__ __forceinline__ void ph_xb_ss(const float* src, bf16* dst, float* SS, int gw, int NGW, int lane) {
    for (int m = gw; m < M_TOK; m += NGW) {
        const f32x4* xr = (const f32x4*)(src + (size_t)m * D_MODEL) + lane;
        f32x4 v[8]; float s = 0.f;
#pragma unroll
        for (int j = 0; j < 8; ++j) { v[j] = xr[64 * j]; s += (v[j].x * v[j].x + v[j].y * v[j].y) + (v[j].z * v[j].z + v[j].w * v[j].w); }
        s = wave_sum(s);
#pragma unroll
        for (int j = 0; j < 8; ++j) { v2u w; w.x = pk2(v[j].x, v[j].y); w.y = pk2(v[j].z, v[j].w); *(v2u*)(dst + xb_off(m, 4 * (lane + 64 * j))) = w; }
        if (lane < 32) SS[(size_t)m * 32 + lane] = (lane == 0) ? s : 0.f;
    }
}
__device__ __forceinline__ void ph_rmsnorm_out(const bf16* src, const float* g, float* dst, int gw, int NGW, int lane) {
    for (int m = gw; m < M_TOK; m += NGW) {
        float v[4][8]; float s = 0.f;
#pragma unroll
        for (int j = 0; j < 4; ++j) { const v4u w = *(const v4u*)(src + xb_off(m, 8 * (lane + 64 * j))); v[j][0] = blo(w.x); v[j][1] = bhi(w.x); v[j][2] = blo(w.y); v[j][3] = bhi(w.y); v[j][4] = blo(w.z); v[j][5] = bhi(w.z); v[j][6] = blo(w.w); v[j][7] = bhi(w.w);
#pragma unroll
            for (int k = 0; k < 8; ++k) s += v[j][k] * v[j][k]; }
        const float r = 1.0f / sqrtf(wave_sum(s) * (1.0f / D_MODEL) + NORM_EPS);
#pragma unroll
        for (int j = 0; j < 4; ++j) { const int c0 = 8 * (lane + 64 * j); const f32x4 g0 = *(const f32x4*)(g + c0), g1 = *(const f32x4*)(g + c0 + 4);
            f32x4 o0, o1; o0.x = v[j][0] * r * g0.x; o0.y = v[j][1] * r * g0.y; o0.z = v[j][2] * r * g0.z; o0.w = v[j][3] * r * g0.w; o1.x = v[j][4] * r * g1.x; o1.y = v[j][5] * r * g1.y; o1.z = v[j][6] * r * g1.z; o1.w = v[j][7] * r * g1.w;
            *(f32x4*)(dst + (size_t)m * D_MODEL + c0) = o0; *(f32x4*)(dst + (size_t)m * D_MODEL + c0 + 4) = o1; }
    }
}
__device__ __forceinline__ void ph_rmsnorm_f32(const float* src, const float* g, float* dst, int gw, int NGW, int lane) {
    for (int m = gw; m < M_TOK; m += NGW) {
        const f32x4* xr = (const f32x4*)(src + (size_t)m * D_MODEL) + lane;
        f32x4 v[8]; float s = 0.f;
#pragma unroll
        for (int j = 0; j < 8; ++j) { v[j] = xr[64 * j]; s += (v[j].x * v[j].x + v[j].y * v[j].y) + (v[j].z * v[j].z + v[j].w * v[j].w); }
        const float r = 1.0f / sqrtf(wave_sum(s) * (1.0f / D_MODEL) + NORM_EPS);
        f32x4* o = (f32x4*)(dst + (size_t)m * D_MODEL) + lane;
#pragma unroll
        for (int j = 0; j < 8; ++j) { const f32x4 gg = ((const f32x4*)g)[lane + 64 * j]; o[64 * j] = v[j] * r * gg; }
    }
}
__device__ __forceinline__ void ph_attn_naive(const bf16* Q, const bf16* K, const bf16* V, const float* sinks, bf16* CAT, int gw, int NGW, int lane) {
    for (int it = gw; it < M_TOK * A_HEADS; it += NGW) {
        const int m = it >> 4, h = it & 15, kvh = h >> 2, b = m >> 12, s = m & (SEQ - 1);
        int k0 = s - (WINDOW - 1); if (k0 < 0) k0 = 0; const int nk = s - k0 + 1;
        float q[64];
        { const v4u* qp = (const v4u*)(Q + (size_t)m * A_WIDTH + h * HD);
#pragma unroll
          for (int c = 0; c < 8; ++c) { const v4u w = qp[c]; q[8 * c + 0] = blo(w.x); q[8 * c + 1] = bhi(w.x); q[8 * c + 2] = blo(w.y); q[8 * c + 3] = bhi(w.y); q[8 * c + 4] = blo(w.z); q[8 * c + 5] = bhi(w.z); q[8 * c + 6] = blo(w.w); q[8 * c + 7] = bhi(w.w); } }
        float sc[2];
#pragma unroll
        for (int r = 0; r < 2; ++r) { const int j = lane + 64 * r; float d = -1e30f;
            if (j < nk) { const v4u* kp = (const v4u*)(K + (size_t)(b * SEQ + k0 + j) * KV_WIDTH + kvh * HD); d = 0.f;
#pragma unroll
                for (int c = 0; c < 8; ++c) { const v4u w = kp[c]; d += q[8 * c + 0] * blo(w.x) + q[8 * c + 1] * bhi(w.x) + q[8 * c + 2] * blo(w.y) + q[8 * c + 3] * bhi(w.y) + q[8 * c + 4] * blo(w.z) + q[8 * c + 5] * bhi(w.z) + q[8 * c + 6] * blo(w.w) + q[8 * c + 7] * bhi(w.w); } }
            sc[r] = d; }
        const float sk = sinks[h];
        const float mx = fmaxf(wave_max(fmaxf(sc[0], sc[1])), sk);
        const float e0 = (lane < nk) ? __expf(sc[0] - mx) : 0.f, e1 = (lane + 64 < nk) ? __expf(sc[1] - mx) : 0.f;
        const float den = wave_sum(e0 + e1) + __expf(sk - mx);
        const float inv = 1.0f / den, p0 = e0 * inv, p1 = e1 * inv;
        float o = 0.f; const bf16* vp = V + (size_t)(b * SEQ + k0) * KV_WIDTH + kvh * HD + lane;
        for (int j = 0; j < nk; ++j) { const float pj = (j < 64) ? __shfl(p0, j) : __shfl(p1, j - 64); o += pj * bf2f(vp[(size_t)j * KV_WIDTH]); }
        CAT[(size_t)m * 2048 + h * HD + lane] = (bf16)f2bf(o);
    }
}
__device__ __forceinline__ void ph_s5_naive(const CAS Params* PP, int e, const bf16* U, bf16* G, LAS unsigned char* lds, int bid, int nblk, int tid_in) {
    LAS float* hbuf = (LAS float*)lds;
    LAS float* ubuf = hbuf + 64 * 132;
    LAS float* cbuf = ubuf + 64 * 16;
    int tid = tid_in; const int lane = tid & 63, wave = __builtin_amdgcn_readfirstlane(tid >> 6);
    const float* a_re = ((const float*)(const GAS float*)PP->in[I_ARE]) + (size_t)e * 64 * 64; const float* a_im = ((const float*)(const GAS float*)PP->in[I_AIM]) + (size_t)e * 64 * 64;
    const float* log_dt = ((const float*)(const GAS float*)PP->in[I_LOGDT]) + (size_t)e * 64;
    const float* b_re = ((const float*)(const GAS float*)PP->in[I_BRE]) + (size_t)e * 64 * 64 * 16; const float* b_im = ((const float*)(const GAS float*)PP->in[I_BIM]) + (size_t)e * 64 * 64 * 16;
    const float* c_re = ((const float*)(const GAS float*)PP->in[I_CRE]) + (size_t)e * 64 * 16 * 64; const float* c_im = ((const float*)(const GAS float*)PP->in[I_CIM]) + (size_t)e * 64 * 16 * 64;
    const float* d_skip = ((const float*)(const GAS float*)PP->in[I_S5D]) + (size_t)e * 1024;
    for (int unit = bid; unit < BATCH * S5_GROUPS; unit += nblk) {
        const int b = unit >> 6, g = unit & 63;
        __syncthreads();
        for (int i = tid; i < 2048; i += 512) { const int c = i >> 7, k = i & 127; cbuf[c * 132 + k] = (k < 64) ? c_re[(size_t)(g * 16 + c) * 64 + k] : -c_im[(size_t)(g * 16 + c) * 64 + (k - 64)]; }
        float abr = 0.f, abi = 0.f, bbr[16], bbi[16], hr = 0.f, hi = 0.f;
#pragma unroll
        for (int c = 0; c < 16; ++c) { bbr[c] = 0.f; bbi[c] = 0.f; }
        if (wave == 0) {
            const int p = lane; const float dt = expf(log_dt[g]); const float ar = a_re[g * 64 + p], ai = a_im[g * 64 + p];
            const float mag = expf(ar * dt); abr = mag * cosf(ai * dt); abi = mag * sinf(ai * dt);
            const float nr = abr - 1.0f, ni = abi, den = ar * ar + ai * ai; const float cr = (nr * ar + ni * ai) / den, ci = (ni * ar - nr * ai) / den;
#pragma unroll
            for (int c = 0; c < 16; ++c) { const float br = b_re[(size_t)(g * 64 + p) * 16 + c], bi = b_im[(size_t)(g * 64 + p) * 16 + c]; bbr[c] = cr * br - ci * bi; bbi[c] = cr * bi + ci * br; }
        }
        for (int chunk = 0; chunk < SEQ / 64; ++chunk) {
            const int m0 = b * SEQ + chunk * 64;
            for (int i = tid; i < 1024; i += 512) { const int t = i >> 4, c = i & 15; ubuf[i] = bf2f(U[(size_t)(m0 + t) * S5_WIDTH + g * 16 + c]); }
            __syncthreads();
            if (wave == 0) {
                for (int t = 0; t < 64; ++t) {
                    const LAS f32x4* up = (const LAS f32x4*)(ubuf + t * 16); float bur = 0.f, bui = 0.f;
#pragma unroll
                    for (int c4 = 0; c4 < 4; ++c4) { const f32x4 u4 = up[c4];
#pragma unroll
                        for (int j = 0; j < 4; ++j) { bur += bbr[4 * c4 + j] * u4[j]; bui += bbi[4 * c4 + j] * u4[j]; } }
                    const float nhr = abr * hr - abi * hi + bur, nhi = abr * hi + abi * hr + bui; hr = nhr; hi = nhi;
                    hbuf[t * 132 + lane] = hr; hbuf[t * 132 + 64 + lane] = hi;
                }
            }
            __syncthreads();
            { const int t = tid >> 3, c0 = 2 * (tid & 7); float y0 = 0.f, y1 = 0.f;
              const LAS f32x4* hp = (const LAS f32x4*)(hbuf + t * 132); const LAS f32x4* ca = (const LAS f32x4*)(cbuf + c0 * 132); const LAS f32x4* cb = (const LAS f32x4*)(cbuf + (c0 + 1) * 132);
#pragma unroll 8
              for (int k4 = 0; k4 < 32; ++k4) { const f32x4 h4 = hp[k4], a4 = ca[k4], b4 = cb[k4]; y0 += (h4.x * a4.x + h4.y * a4.y) + (h4.z * a4.z + h4.w * a4.w); y1 += (h4.x * b4.x + h4.y * b4.y) + (h4.z * b4.z + h4.w * b4.w); }
              y0 += d_skip[g * 16 + c0] * ubuf[t * 16 + c0]; y1 += d_skip[g * 16 + c0 + 1] * ubuf[t * 16 + c0 + 1];
              *(unsigned*)(G + (size_t)(m0 + t) * S5_WIDTH + g * 16 + c0) = pk2(gelu_tanh(y0), gelu_tanh(y1)); }
            __syncthreads();
        }
    }
}
__device__ __forceinline__ void ph_conv(int do_dt, const bf16* XBC, const float* cw, const float* cb, const float* dt_bias, bf16* XBCC, float* DT, int gw, int NGW, int lane, int gtid, int gthreads) {
    constexpr int RUN = 32, NCB = M_CONV_DIM / 512, NRUN = M_TOK / RUN;
    for (int it = gw; it < NCB * NRUN; it += NGW) {
        const int cbk = it % NCB, run = it / NCB, c8 = cbk * 512 + lane * 8, m0 = run * RUN, s0 = m0 & (SEQ - 1);
        float w[4][8], bias[8];
#pragma unroll
        for (int tap = 0; tap < 4; ++tap) { const f32x4 a = *(const f32x4*)(cw + (size_t)tap * M_CONV_DIM + c8), b = *(const f32x4*)(cw + (size_t)tap * M_CONV_DIM + c8 + 4);
            w[tap][0] = a.x; w[tap][1] = a.y; w[tap][2] = a.z; w[tap][3] = a.w; w[tap][4] = b.x; w[tap][5] = b.y; w[tap][6] = b.z; w[tap][7] = b.w; }
        { const f32x4 a = *(const f32x4*)(cb + c8), b = *(const f32x4*)(cb + c8 + 4); bias[0] = a.x; bias[1] = a.y; bias[2] = a.z; bias[3] = a.w; bias[4] = b.x; bias[5] = b.y; bias[6] = b.z; bias[7] = b.w; }
        v4u h0, h1, h2;
        { unsigned z0 = 0u; asm volatile("" : "+v"(z0)); const v4u z = (v4u){z0, z0, z0, z0};
          const bf16* p = XBC + (size_t)m0 * M_CONV_DIM + c8;
          h0 = (s0 >= 3) ? *(const v4u*)(p - 3 * (size_t)M_CONV_DIM) : z; h1 = (s0 >= 2) ? *(const v4u*)(p - 2 * (size_t)M_CONV_DIM) : z; h2 = (s0 >= 1) ? *(const v4u*)(p - (size_t)M_CONV_DIM) : z; }
        v4u ina[8], inb[8];
#define CONV_LOAD(dst, T0) _Pragma("unroll") for (int t = 0; t < 8; ++t) dst[t] = *(const v4u*)(XBC + (size_t)(m0 + (T0) + t) * M_CONV_DIM + c8)
#define CONV_TAP(tap, v) acc[0] += w[tap][0] * blo(v.x); acc[1] += w[tap][1] * bhi(v.x); acc[2] += w[tap][2] * blo(v.y); acc[3] += w[tap][3] * bhi(v.y); \
                         acc[4] += w[tap][4] * blo(v.z); acc[5] += w[tap][5] * bhi(v.z); acc[6] += w[tap][6] * blo(v.w); acc[7] += w[tap][7] * bhi(v.w);
#define CONV_BATCH(src, T0) _Pragma("unroll") for (int t = 0; t < 8; ++t) { const v4u cur = src[t]; float acc[8]; \
                _Pragma("unroll") for (int j = 0; j < 8; ++j) acc[j] = bias[j]; \
                CONV_TAP(0, h0) CONV_TAP(1, h1) CONV_TAP(2, h2) CONV_TAP(3, cur) \
                v4u o; o.x = pkbf(acc[0] * fsig(acc[0]), acc[1] * fsig(acc[1])); o.y = pkbf(acc[2] * fsig(acc[2]), acc[3] * fsig(acc[3])); \
                o.z = pkbf(acc[4] * fsig(acc[4]), acc[5] * fsig(acc[5])); o.w = pkbf(acc[6] * fsig(acc[6]), acc[7] * fsig(acc[7])); \
                *(v4u*)(XBCC + (size_t)(m0 + (T0) + t) * M_CONV_DIM + c8) = o; \
                h0 = h1; h1 = h2; h2 = cur; }
        CONV_LOAD(ina, 0);
#pragma unroll 1
        for (int t0 = 0; t0 < RUN; t0 += 16) {
            CONV_LOAD(inb, t0 + 8); __builtin_amdgcn_sched_barrier(0);
            CONV_BATCH(ina, t0)
            if (t0 + 16 < RUN) { CONV_LOAD(ina, t0 + 16); } __builtin_amdgcn_sched_barrier(0);
            CONV_BATCH(inb, t0 + 8)
        }
#undef CONV_LOAD
#undef CONV_TAP
#undef CONV_BATCH
    }
    if (do_dt) for (int i = gtid; i < M_TOK * M_HEADS; i += gthreads) DT[i] = softplusf_(DT[i] + dt_bias[i & 63]);
}
__device__ __forceinline__ void ph_ssd_naive(const bf16* XBCC, const float* DT, const bf16* Z, const float* a_log, const float* d_skip, bf16* YG, LAS unsigned char* lds, int bid, int nblk, int tid_in) {
    LAS float* xs = (LAS float*)lds;
    LAS float* Bs = xs + 32 * 64;
    LAS float* Cs = Bs + 32 * 128;
    LAS float* ys = Cs + 32 * 128;
    LAS float* dts = ys + 32 * 64;
    LAS float* das = dts + 32;
    int tid = tid_in; const int p = tid >> 3, nb = tid & 7;
    for (int unit = bid; unit < BATCH * M_HEADS; unit += nblk) {
        const int b = unit >> 6, h = unit & 63, grp = h >> 3; const float a = -expf(a_log[h]), Dh = d_skip[h];
        float S[16];
#pragma unroll
        for (int i = 0; i < 16; ++i) S[i] = 0.f;
        for (int chunk = 0; chunk < SEQ / 32; ++chunk) {
            const int m0 = b * SEQ + chunk * 32;
            { const int t = (tid * 4) >> 6, pp = (tid * 4) & 63; const v2u w = *(const v2u*)(XBCC + (size_t)(m0 + t) * M_CONV_DIM + h * 64 + pp);
              *(LAS f32x4*)(xs + t * 64 + pp) = (f32x4){blo(w.x), bhi(w.x), blo(w.y), bhi(w.y)}; }
            { const int t = (tid * 8) >> 7, n = (tid * 8) & 127;
              const v4u wb = *(const v4u*)(XBCC + (size_t)(m0 + t) * M_CONV_DIM + 4096 + grp * 128 + n), wc = *(const v4u*)(XBCC + (size_t)(m0 + t) * M_CONV_DIM + 5120 + grp * 128 + n);
              *(LAS f32x4*)(Bs + t * 128 + n) = (f32x4){blo(wb.x), bhi(wb.x), blo(wb.y), bhi(wb.y)}; *(LAS f32x4*)(Bs + t * 128 + n + 4) = (f32x4){blo(wb.z), bhi(wb.z), blo(wb.w), bhi(wb.w)};
              *(LAS f32x4*)(Cs + t * 128 + n) = (f32x4){blo(wc.x), bhi(wc.x), blo(wc.y), bhi(wc.y)}; *(LAS f32x4*)(Cs + t * 128 + n + 4) = (f32x4){blo(wc.z), bhi(wc.z), blo(wc.w), bhi(wc.w)}; }
            if (tid < 32) { const float dt = DT[(size_t)(m0 + tid) * 64 + h]; dts[tid] = dt; das[tid] = __expf(a * dt); }
            __syncthreads();
            for (int t = 0; t < 32; ++t) {
                const float dA = das[t], xv = xs[t * 64 + p], xdt = xv * dts[t]; float acc = 0.f;
#pragma unroll
                for (int i4 = 0; i4 < 4; ++i4) { const f32x4 B4 = *(const LAS f32x4*)(Bs + t * 128 + nb * 16 + 4 * i4), C4 = *(const LAS f32x4*)(Cs + t * 128 + nb * 16 + 4 * i4);
#pragma unroll
                    for (int j = 0; j < 4; ++j) { S[4 * i4 + j] = S[4 * i4 + j] * dA + xdt * B4[j]; acc += C4[j] * S[4 * i4 + j]; } }
                acc += __shfl_xor(acc, 1); acc += __shfl_xor(acc, 2); acc += __shfl_xor(acc, 4);
                if (nb == 0) ys[t * 64 + p] = acc + Dh * xv;
            }
            __syncthreads();
            { const int t = (tid * 4) >> 6, pp = (tid * 4) & 63; const f32x4 y4 = *(const LAS f32x4*)(ys + t * 64 + pp);
              const v2u zw = *(const v2u*)(Z + (size_t)(m0 + t) * M_INNER + h * 64 + pp);
              v2u o; o.x = pk2(y4.x * siluf_(blo(zw.x)), y4.y * siluf_(bhi(zw.x))); o.y = pk2(y4.z * siluf_(blo(zw.y)), y4.w * siluf_(bhi(zw.y)));
              *(v2u*)(YG + (size_t)(m0 + t) * M_INNER + h * 64 + pp) = o; }
        }
        __syncthreads();
    }
}
__device__ __forceinline__ void ph_gnorm(const bf16* YG, const float* ng, bf16* YN, int gw, int NGW, int lane) {
    for (int m = gw; m < M_TOK; m += NGW) {
#pragma unroll 2
        for (int g8 = 0; g8 < 8; ++g8) {
            const v4u w = *(const v4u*)(YG + (size_t)m * M_INNER + g8 * 512 + lane * 8);
            float v[8] = {blo(w.x), bhi(w.x), blo(w.y), bhi(w.y), blo(w.z), bhi(w.z), blo(w.w), bhi(w.w)};
            float s = 0.f;
#pragma unroll
            for (int j = 0; j < 8; ++j) s += v[j] * v[j];
            const float r = 1.0f / sqrtf(wave_sum(s) * (1.0f / 512.0f) + NORM_EPS);
            const f32x4 g0 = *(const f32x4*)(ng + g8 * 512 + lane * 8), g1 = *(const f32x4*)(ng + g8 * 512 + lane * 8 + 4);
            v4u o; o.x = pk2(v[0] * r * g0.x, v[1] * r * g0.y); o.y = pk2(v[2] * r * g0.z, v[3] * r * g0.w); o.z = pk2(v[4] * r * g1.x, v[5] * r * g1.y); o.w = pk2(v[6] * r * g1.z, v[7] * r * g1.w);
            *(v4u*)(YN + (size_t)m * M_INNER + g8 * 512 + lane * 8) = o;
        }
    }
}


typedef short bf16x8v __attribute__((ext_vector_type(8)));
typedef short s16x4v __attribute__((ext_vector_type(4)));
typedef float f32x16 __attribute__((ext_vector_type(16)));
#define MFMA32(a, b, c) __builtin_amdgcn_mfma_f32_32x32x16_bf16((a), (b), (c), 0, 0, 0)
__device__ __forceinline__ int crow(int reg, int h) { return (reg & 3) + 8 * (reg >> 2) + 4 * h; }
__device__ __forceinline__ bf16x8v pack8(const f32x16& x, int s) {
    v4u p; p.x = pkbf(x[8 * s + 0], x[8 * s + 1]); p.y = pkbf(x[8 * s + 2], x[8 * s + 3]); p.z = pkbf(x[8 * s + 4], x[8 * s + 5]); p.w = pkbf(x[8 * s + 6], x[8 * s + 7]);
    return __builtin_bit_cast(bf16x8v, p);
}
__device__ __forceinline__ bf16x8v tr_frag(const LAS bf16* base, int stride, int rowA, int rowB, int ctile, int lane) {
    const int i16 = lane & 15, q = i16 >> 2, pp = i16 & 3, c0 = ctile + 16 * ((lane >> 4) & 1) + 4 * pp;
    const s16x4v lo = __builtin_amdgcn_ds_read_tr16_b64_v4i16((LAS s16x4v*)(base + (rowA + q) * stride + c0));
    const s16x4v hi = __builtin_amdgcn_ds_read_tr16_b64_v4i16((LAS s16x4v*)(base + (rowB + q) * stride + c0));
    return __builtin_shufflevector(lo, hi, 0, 1, 2, 3, 4, 5, 6, 7);
}
__device__ __forceinline__ bf16x8v row_frag(const LAS bf16* base, int stride, int row, int k0) { return *(const LAS bf16x8v*)(base + row * stride + k0); }

__device__ __forceinline__ void ph_attn_mfma(const bf16* Q, const bf16* K, const bf16* V, const float* sinks, bf16* CAT, LAS unsigned char* lds, int bid, int nblk, int tid_in) {
    constexpr int KS = 72;
    LAS bf16* Ks = (LAS bf16*)lds; LAS bf16* Vs = Ks + 256 * KS;
    int tid = tid_in;
    const int lane = tid & 63, wave = __builtin_amdgcn_readfirstlane(tid >> 6), r = lane & 31, h = lane >> 5;
    for (int unit = bid; unit < BATCH * (SEQ / 128) * A_KV; unit += nblk) {
        const int b = unit >> 7, blk = (unit & 127) >> 2, kvh = unit & 3;
        const int m0 = b * SEQ + blk * 128;
        LDS_BARRIER();
#pragma unroll
        for (int i = 0; i < 4; ++i) { const int c = tid + 512 * i, row = c >> 3, c8 = (c & 7) * 8;
            unsigned z0 = 0u; asm volatile("" : "+v"(z0));
            v4u kv = (v4u){z0, z0, z0, z0}, vv = kv;
            if (blk > 0 || row >= 128) { const size_t go = (size_t)(m0 - 128 + row) * KV_WIDTH + kvh * HD + c8; kv = *(const v4u*)(K + go); vv = *(const v4u*)(V + go); }
            *(LAS v4u*)(Ks + row * KS + c8) = kv; *(LAS v4u*)(Vs + row * KS + c8) = vv; }
        LDS_BARRIER();
        const int g = wave & 3, qh = wave >> 2, head = kvh * 4 + g; const float sink = sinks[head];
#pragma unroll 1
        for (int qt = 0; qt < 2; ++qt) {
            const int i0 = qh * 64 + qt * 32, kt0 = i0 >> 5, iq = i0 + r;
            bf16x8v Qf[4];
#pragma unroll
            for (int kk = 0; kk < 4; ++kk) Qf[kk] = *(const bf16x8v*)(Q + (size_t)(m0 + iq) * A_WIDTH + head * HD + 16 * kk + 8 * h);
            f32x16 S[5];
#pragma unroll
            for (int t = 0; t < 5; ++t) {
#pragma unroll
                for (int i = 0; i < 16; ++i) S[t][i] = 0.f;
#pragma unroll
                for (int kk = 0; kk < 4; ++kk) S[t] = MFMA32(row_frag(Ks, KS, 32 * (kt0 + t) + r, 16 * kk + 8 * h), Qf[kk], S[t]);
            }
            float mx = -1e30f;
#pragma unroll
            for (int t = 0; t < 5; ++t)
#pragma unroll
                for (int i = 0; i < 16; ++i) { const int j = 32 * (kt0 + t) + crow(i, h); const bool valid = (j >= iq + 1) && (j <= iq + 128) && (blk > 0 || j >= 128);
                    const float s = valid ? S[t][i] : -1e30f; S[t][i] = s; mx = fmaxf(mx, s); }
            mx = fmaxf(mx, __shfl_xor(mx, 32)); mx = fmaxf(mx, sink);
            float sum = 0.f;
#pragma unroll
            for (int t = 0; t < 5; ++t)
#pragma unroll
                for (int i = 0; i < 16; ++i) { const float p = __expf(S[t][i] - mx); S[t][i] = p; sum += p; }
            sum += __shfl_xor(sum, 32); sum += __expf(sink - mx);
            const float inv = 1.0f / sum;
            f32x16 O[2];
#pragma unroll
            for (int i = 0; i < 16; ++i) { O[0][i] = 0.f; O[1][i] = 0.f; }
#pragma unroll
            for (int t = 0; t < 5; ++t) {
#pragma unroll
                for (int i = 0; i < 16; ++i) S[t][i] *= inv;
#pragma unroll
                for (int sp = 0; sp < 2; ++sp) { const bf16x8v Af = pack8(S[t], sp); const int rowA = 32 * (kt0 + t) + 16 * sp + 4 * h;
#pragma unroll
                    for (int dt = 0; dt < 2; ++dt) O[dt] = MFMA32(Af, tr_frag(Vs, KS, rowA, rowA + 8, 32 * dt, lane), O[dt]); }
            }
#pragma unroll
            for (int dt = 0; dt < 2; ++dt)
#pragma unroll
                for (int i = 0; i < 16; ++i) CAT[(size_t)(m0 + i0 + crow(i, h)) * 2048 + head * HD + 32 * dt + r] = (bf16)(pkbf(O[dt][i], 0.f) & 0xffffu);
        }
    }
    LDS_BARRIER();
}

__device__ __forceinline__ void ph_ssd_mfma(const bf16* XBCC, const float* DT, const bf16* Z, const float* a_log, const float* d_skip, bf16* YG, float* SSG, LAS unsigned char* lds, int bid, int nblk, int tid_in) {
    constexpr int BS = 136, XS = 72;
    LAS bf16* Bs = (LAS bf16*)lds;
    LAS bf16* Cs = Bs + 128 * BS;
    LAS bf16* xs = Cs + 128 * BS;
    LAS bf16* xw = xs + 128 * XS;
    LAS bf16* Sb = xw + 128 * XS;
    LAS float* acum = (LAS float*)(Sb + 64 * BS);
    LAS float* dl = acum + 128;
    LAS float* wsd = dl + 128;
    LAS float* dtv = wsd + 128;
    constexpr int YS = 68;
    LAS float* ybuf = dtv + 128;
    LAS float* fsv = ybuf + 128 * YS;
    int tid = tid_in;
    const int lane = tid & 63, wave = __builtin_amdgcn_readfirstlane(tid >> 6), r = lane & 31, h = lane >> 5;
    const int orow = tid >> 2, ocg = (tid & 3) * 16;
    const int li = (int)((0x11002233u >> (4 * wave)) & 15u), hf = (int)((0x5Au >> wave) & 1u);
    const int sp_t = wave >> 2, sn_t = wave & 3;
    if (wave < 4) __builtin_amdgcn_s_setprio(1);
    for (int unit = bid; unit < BATCH * M_HEADS; unit += nblk) {
        const int gg = (unit & 7) * 4 + (unit >> 6), b = gg >> 3, grp = gg & 7, hd = grp * 8 + ((unit >> 3) & 7); const float a = -expf(a_log[hd]), Dh = d_skip[hd];
        f32x16 Sacc;
#pragma unroll
        for (int i = 0; i < 16; ++i) Sacc[i] = 0.f;
        LDS_BARRIER();
        { unsigned on3 = ~0u; asm volatile("" : "+s"(on3));
          const int tz = wave * 64 + (int)__builtin_amdgcn_mbcnt_hi(on3, __builtin_amdgcn_mbcnt_lo(on3, 0u));
          for (int i = tz; i < 64 * BS / 2; i += 512) ((LAS unsigned*)Sb)[i] = 0u; }
        v4u nb[4], nc[4], nx[2]; float nd0, nd1;
        { const int m0 = b * SEQ;
#pragma unroll
          for (int i = 0; i < 4; ++i) { const int c = tid + 512 * i, row = c >> 4, c8 = (c & 15) * 8; const size_t go = (size_t)(m0 + row) * M_CONV_DIM + 4096 + grp * 128 + c8; nb[i] = *(const v4u*)(XBCC + go); nc[i] = *(const v4u*)(XBCC + go + 1024); }
#pragma unroll
          for (int i = 0; i < 2; ++i) { const int c = tid + 512 * i, row = c >> 3, c8 = (c & 7) * 8; nx[i] = *(const v4u*)(XBCC + (size_t)(m0 + row) * M_CONV_DIM + hd * 64 + c8); }
          nd0 = DT[(size_t)(m0 + 2 * lane) * 64 + hd]; nd1 = DT[(size_t)(m0 + 2 * lane + 1) * 64 + hd]; }
#pragma unroll 1
        for (int chunk = 0; chunk < SEQ / 128; ++chunk) {
            const int m0 = b * SEQ + chunk * 128;
#pragma unroll
            for (int i = 0; i < 4; ++i) { const int c = tid + 512 * i, row = c >> 4, c8 = (c & 15) * 8; *(LAS v4u*)(Bs + row * BS + c8) = nb[i]; *(LAS v4u*)(Cs + row * BS + c8) = nc[i]; }
            { const float d0 = nd0, d1 = nd1; const float v0 = a * d0, v1 = a * d1; float sc = v0 + v1;
#pragma unroll
              for (int o = 1; o < 64; o <<= 1) { const float t = __shfl_up(sc, o); if (lane >= o) sc += t; }
              const float c1 = sc, c0 = sc - v1; const float tot = __shfl(sc, 63);
              *(LAS f32x2v*)(acum + 2 * lane) = (f32x2v){c0, c1}; *(LAS f32x2v*)(dl + 2 * lane) = (f32x2v){__expf(c0), __expf(c1)};
              *(LAS f32x2v*)(wsd + 2 * lane) = (f32x2v){d0 * __expf(tot - c0), d1 * __expf(tot - c1)}; *(LAS f32x2v*)(dtv + 2 * lane) = (f32x2v){d0, d1};
              const float ce = __shfl(c1, lane | 15);
              *(LAS f32x2v*)(fsv + 2 * lane) = (f32x2v){d0 * __expf(ce - c0), d1 * __expf(ce - c1)}; }
#pragma unroll
            for (int i = 0; i < 2; ++i) { const int c = tid + 512 * i, row = c >> 3, c8 = (c & 7) * 8; const v4u w = nx[i]; const float f = wsd[row];
                *(LAS v4u*)(xs + row * XS + c8) = w;
                v4u o; o.x = pkbf(blo(w.x) * f, bhi(w.x) * f); o.y = pkbf(blo(w.y) * f, bhi(w.y) * f); o.z = pkbf(blo(w.z) * f, bhi(w.z) * f); o.w = pkbf(blo(w.w) * f, bhi(w.w) * f);
                *(LAS v4u*)(xw + row * XS + c8) = o; }
            if (chunk + 1 < SEQ / 128) { const int m1 = m0 + 128;
#pragma unroll
                for (int i = 0; i < 4; ++i) { const int c = tid + 512 * i, row = c >> 4, c8 = (c & 15) * 8; const size_t go = (size_t)(m1 + row) * M_CONV_DIM + 4096 + grp * 128 + c8; nb[i] = *(const v4u*)(XBCC + go); nc[i] = *(const v4u*)(XBCC + go + 1024); }
#pragma unroll
                for (int i = 0; i < 2; ++i) { const int c = tid + 512 * i, row = c >> 3, c8 = (c & 7) * 8; nx[i] = *(const v4u*)(XBCC + (size_t)(m1 + row) * M_CONV_DIM + hd * 64 + c8); }
                nd0 = DT[(size_t)(m1 + 2 * lane) * 64 + hd]; nd1 = DT[(size_t)(m1 + 2 * lane + 1) * 64 + hd]; }
            LDS_BARRIER();
            v4u zr[2];
            { const bf16* zp = Z + (size_t)(m0 + orow) * M_INNER + hd * 64 + ocg; zr[0] = *(const v4u*)zp; zr[1] = *(const v4u*)(zp + 8); }
            f32x16 acc[2];
#pragma unroll
            for (int i = 0; i < 16; ++i) { acc[0][i] = 0.f; acc[1][i] = 0.f; }
            {
                f32x16 a2;
#pragma unroll
                for (int i = 0; i < 16; ++i) a2[i] = 0.f;
#pragma unroll
                for (int kh = 0; kh < 2; ++kh) {
                    bf16x8v Cf[4], Xf[4];
#pragma unroll
                    for (int kk = 0; kk < 4; ++kk) { Cf[kk] = row_frag(Cs, BS, 32 * li + r, 64 * kh + 16 * kk + 8 * h); Xf[kk] = row_frag(Sb, BS, 32 * hf + r, 64 * kh + 16 * kk + 8 * h); }
                    __builtin_amdgcn_sched_barrier(0);
#pragma unroll
                    for (int kk = 0; kk < 4; ++kk) a2 = MFMA32(Cf[kk], Xf[kk], a2);
                }
#pragma unroll
                for (int i = 0; i < 16; ++i) { const int l = 32 * li + crow(i, h); a2[i] = a2[i] * dl[l] + Dh * bf2f(xs[l * XS + 32 * hf + r]); }
                if (hf) acc[1] = a2; else acc[0] = a2;
            }
            const int lcol = 32 * li + r; const float al = acum[lcol];
#pragma unroll 1
            for (int j = hf; j <= li; j += 2) {
                f32x16 T;
#pragma unroll
                for (int i = 0; i < 16; ++i) T[i] = 0.f;
#pragma unroll
                for (int kh = 0; kh < 2; ++kh) {
                    bf16x8v Cf[4], Xf[4];
#pragma unroll
                    for (int kk = 0; kk < 4; ++kk) { Xf[kk] = row_frag(Bs, BS, 32 * j + r, 64 * kh + 16 * kk + 8 * h); Cf[kk] = row_frag(Cs, BS, 32 * li + r, 64 * kh + 16 * kk + 8 * h); }
                    __builtin_amdgcn_sched_barrier(0);
#pragma unroll
                    for (int kk = 0; kk < 4; ++kk) T = MFMA32(Xf[kk], Cf[kk], T);
                }
                if (j < li) {
                    const float fl = __expf(al - acum[32 * j + 31]);
#pragma unroll
                    for (int q = 0; q < 4; ++q) { const f32x4 f4 = *(const LAS f32x4*)(fsv + 32 * j + 4 * h + 8 * q);
#pragma unroll
                        for (int k = 0; k < 4; ++k) T[4 * q + k] *= f4[k] * fl; }
                } else {
#pragma unroll
                    for (int q = 0; q < 4; ++q) { const f32x4 ac4 = *(const LAS f32x4*)(acum + 32 * j + 4 * h + 8 * q), dt4 = *(const LAS f32x4*)(dtv + 32 * j + 4 * h + 8 * q);
#pragma unroll
                        for (int k = 0; k < 4; ++k) { const int s = 32 * j + 8 * q + 4 * h + k; const float e = __expf(fminf(al - ac4[k], 0.f)) * dt4[k]; T[4 * q + k] *= (s <= lcol) ? e : 0.f; } }
                }
                const bf16x8v pa0 = pack8(T, 0), pa1 = pack8(T, 1); const int rowA = 32 * j + 4 * h;
#pragma unroll
                for (int pp = 0; pp < 2; ++pp) { const bf16x8v x0 = tr_frag(xs, XS, rowA, rowA + 8, 32 * pp, lane), x1 = tr_frag(xs, XS, rowA + 16, rowA + 24, 32 * pp, lane);
                    acc[pp] = MFMA32(pa0, x0, acc[pp]); acc[pp] = MFMA32(pa1, x1, acc[pp]); }
            }
            if (hf == 0) {
#pragma unroll
                for (int pp = 0; pp < 2; ++pp)
#pragma unroll
                    for (int i = 0; i < 16; ++i) ybuf[(32 * li + crow(i, h)) * YS + 32 * pp + r] = acc[pp][i];
            }
            { const float dtot = dl[127];
#pragma unroll
              for (int i = 0; i < 16; ++i) Sacc[i] *= dtot;
#pragma unroll
              for (int kh = 0; kh < 2; ++kh) { bf16x8v Af[4], Bf[4];
#pragma unroll
                  for (int kk = 0; kk < 4; ++kk) { const int rowA = 64 * kh + 16 * kk + 8 * h; Af[kk] = tr_frag(xw, XS, rowA, rowA + 4, 32 * sp_t, lane); Bf[kk] = tr_frag(Bs, BS, rowA, rowA + 4, 32 * sn_t, lane); }
                  __builtin_amdgcn_sched_barrier(0);
#pragma unroll
                  for (int kk = 0; kk < 4; ++kk) Sacc = MFMA32(Af[kk], Bf[kk], Sacc); } }
            LDS_BARRIER();
            if (hf == 1) {
#pragma unroll
                for (int pp = 0; pp < 2; ++pp)
#pragma unroll
                    for (int i = 0; i < 16; ++i) { LAS float* q = ybuf + (32 * li + crow(i, h)) * YS + 32 * pp + r; *q = *q + acc[pp][i]; }
            }
            LDS_BARRIER();
#pragma unroll
            for (int i = 0; i < 16; ++i) Sb[(32 * sp_t + crow(i, h)) * BS + 32 * sn_t + r] = (bf16)(pkbf(Sacc[i], 0.f) & 0xffffu);
            { const LAS f32x4* yp = (const LAS f32x4*)(ybuf + orow * YS + ocg);
              bf16* op = YG + ((size_t)(((m0 + orow) >> 8) * M_HEADS + hd) * 256 + ((m0 + orow) & 255)) * 64 + ocg;
              float qs = 0.f;
#pragma unroll
              for (int q = 0; q < 2; ++q) { const f32x4 y0 = yp[2 * q], y1 = yp[2 * q + 1]; const v4u zw = zr[q];
                  const float g0 = y0.x * siluf_(blo(zw.x)), g1 = y0.y * siluf_(bhi(zw.x)), g2 = y0.z * siluf_(blo(zw.y)), g3 = y0.w * siluf_(bhi(zw.y));
                  const float g4 = y1.x * siluf_(blo(zw.z)), g5 = y1.y * siluf_(bhi(zw.z)), g6 = y1.z * siluf_(blo(zw.w)), g7 = y1.w * siluf_(bhi(zw.w));
                  qs += ((g0 * g0 + g1 * g1) + (g2 * g2 + g3 * g3)) + ((g4 * g4 + g5 * g5) + (g6 * g6 + g7 * g7));
                  v4u o; o.x = pkbf(g0, g1); o.y = pkbf(g2, g3); o.z = pkbf(g4, g5); o.w = pkbf(g6, g7);
                  *(v4u*)(op + 8 * q) = o; }
              qs += __shfl_xor(qs, 1); qs += __shfl_xor(qs, 2);
              if ((tid & 3) == 0) SSG[(size_t)(m0 + orow) * 64 + hd] = qs; }
        }
    }
    __builtin_amdgcn_s_setprio(0);
    LDS_BARRIER();
}

__device__ __forceinline__ void ph_s5_mfma(const CAS Params* PP, int e, const bf16* U, bf16* G, LAS unsigned char* lds, int bid, int nblk, int tid_in) {
    constexpr int BU = 132, HS = 136;
    LAS float* bu = (LAS float*)lds;
    LAS bf16* hs = (LAS bf16*)(bu + 2 * 64 * BU);
    int tid = tid_in;
    const int lane = tid & 63, wave = __builtin_amdgcn_readfirstlane(tid >> 6), r = lane & 31, h = lane >> 5;
    const float* a_re = ((const float*)(const GAS float*)PP->in[I_ARE]) + (size_t)e * 64 * 64; const float* a_im = ((const float*)(const GAS float*)PP->in[I_AIM]) + (size_t)e * 64 * 64;
    const float* log_dt = ((const float*)(const GAS float*)PP->in[I_LOGDT]) + (size_t)e * 64;
    const float* b_re = ((const float*)(const GAS float*)PP->in[I_BRE]) + (size_t)e * 64 * 64 * 16; const float* b_im = ((const float*)(const GAS float*)PP->in[I_BIM]) + (size_t)e * 64 * 64 * 16;
    const float* c_re = ((const float*)(const GAS float*)PP->in[I_CRE]) + (size_t)e * 64 * 16 * 64; const float* c_im = ((const float*)(const GAS float*)PP->in[I_CIM]) + (size_t)e * 64 * 16 * 64;
    const float* d_skip = ((const float*)(const GAS float*)PP->in[I_S5D]) + (size_t)e * 1024;
    for (int unit = bid; unit < BATCH * S5_GROUPS; unit += nblk) {
        const int b = unit >> 6, g = unit & 63; const float dt = expf(log_dt[g]);
        LDS_BARRIER();
        if (wave == 1 || wave == 2) {
            bf16x8v Bf[4];
#pragma unroll
            for (int kt = 0; kt < 4; ++kt) { const int k = 32 * kt + r, p = k >> 1, ri = k & 1;
                const float ar = a_re[g * 64 + p], ai = a_im[g * 64 + p]; const float mag = expf(ar * dt), abr = mag * cosf(ai * dt), abi = mag * sinf(ai * dt);
                const float nr = abr - 1.0f, ni = abi, den = ar * ar + ai * ai; const float cr = (nr * ar + ni * ai) / den, ci = (ni * ar - nr * ai) / den;
                float v[8];
#pragma unroll
                for (int j = 0; j < 8; ++j) { const float br = b_re[(size_t)(g * 64 + p) * 16 + 8 * h + j], bi = b_im[(size_t)(g * 64 + p) * 16 + 8 * h + j]; v[j] = ri ? (cr * bi + ci * br) : (cr * br - ci * bi); }
                v4u w; w.x = pkbf(v[0], v[1]); w.y = pkbf(v[2], v[3]); w.z = pkbf(v[4], v[5]); w.w = pkbf(v[6], v[7]); Bf[kt] = __builtin_bit_cast(bf16x8v, w); }
            const int tt = wave - 1;
            bf16x8v un = *(const bf16x8v*)(U + (size_t)(b * SEQ + 32 * tt + r) * S5_WIDTH + g * 16 + 8 * h);
#pragma unroll 1
            for (int i = 0; i < SEQ / 64 + 2; ++i) {
                if (i < SEQ / 64) {
                    const bf16x8v uc = un;
                    if (i + 1 < SEQ / 64) un = *(const bf16x8v*)(U + (size_t)(b * SEQ + (i + 1) * 64 + 32 * tt + r) * S5_WIDTH + g * 16 + 8 * h);
                    LAS float* dst = bu + (i & 1) * 64 * BU;
#pragma unroll
                    for (int kt = 0; kt < 4; ++kt) { f32x16 z;
#pragma unroll
                        for (int q = 0; q < 16; ++q) z[q] = 0.f;
                        const f32x16 d = MFMA32(uc, Bf[kt], z);
#pragma unroll
                        for (int q = 0; q < 16; ++q) dst[(32 * tt + crow(q, h)) * BU + 32 * kt + r] = d[q]; }
                }
                LDS_BARRIER();
            }
        } else if (wave == 0) {
            const int p = lane; const float ar = a_re[g * 64 + p], ai = a_im[g * 64 + p]; const float mag = expf(ar * dt), abr = mag * cosf(ai * dt), abi = mag * sinf(ai * dt);
            typedef float f2 __attribute__((ext_vector_type(2)));
            f2 hv = {0.f, 0.f}; const f2 av = {abr, abr}, bv = {-abi, abi};
#pragma unroll 1
            for (int i = 0; i < SEQ / 64 + 2; ++i) {
                if (i >= 1 && i <= SEQ / 64) {
                    const LAS float* src = bu + ((i - 1) & 1) * 64 * BU + 2 * p;
                    unsigned da = (unsigned)(size_t)(hs + ((i - 1) & 1) * 64 * HS + 2 * p); asm volatile("" : "+v"(da)); LAS bf16* dst = (LAS bf16*)(size_t)da;
                    f2 ba[16], bc[16];
#define S5_LD(arr, T0) _Pragma("unroll") for (int j = 0; j < 16; ++j) arr[j] = *(const LAS f2*)(src + ((T0) + j) * BU)
#define S5_PROC(arr, T0) _Pragma("unroll") for (int j = 0; j < 16; ++j) { const f2 sw = __builtin_shufflevector(hv, hv, 1, 0); const f2 t = __builtin_elementwise_fma(bv, sw, arr[j]); hv = __builtin_elementwise_fma(av, hv, t); \
                            *(LAS unsigned*)(dst + ((T0) + j) * HS) = pkbf(hv.x, hv.y); }
                    S5_LD(ba, 0); S5_LD(bc, 16); __builtin_amdgcn_sched_barrier(0);
                    S5_PROC(ba, 0); __builtin_amdgcn_sched_barrier(0); S5_LD(ba, 32); __builtin_amdgcn_sched_barrier(0);
                    S5_PROC(bc, 16); __builtin_amdgcn_sched_barrier(0); S5_LD(bc, 48); __builtin_amdgcn_sched_barrier(0);
                    S5_PROC(ba, 32); __builtin_amdgcn_sched_barrier(0);
                    S5_PROC(bc, 48);
#undef S5_LD
#undef S5_PROC
                }
                LDS_BARRIER();
            }
        } else if (wave == 3 || wave == 6) {
            bf16x8v Cf[8];
#pragma unroll
            for (int kk = 0; kk < 8; ++kk) { float v[8];
#pragma unroll
                for (int j = 0; j < 8; ++j) { const int k = 16 * kk + 8 * h + j, p = k >> 1; v[j] = (r < 16) ? ((k & 1) ? -c_im[(size_t)(g * 16 + (r & 15)) * 64 + p] : c_re[(size_t)(g * 16 + (r & 15)) * 64 + p]) : 0.f; }
                v4u w; w.x = pkbf(v[0], v[1]); w.y = pkbf(v[2], v[3]); w.z = pkbf(v[4], v[5]); w.w = pkbf(v[6], v[7]); Cf[kk] = __builtin_bit_cast(bf16x8v, w); }
            const int tt = (wave == 6) ? 1 : 0; const float dsk = d_skip[g * 16 + (r & 15)];
            unsigned short un[16];
#pragma unroll
            for (int q = 0; q < 16; ++q) un[q] = U[(size_t)(b * SEQ + 32 * tt + crow(q, h)) * S5_WIDTH + g * 16 + (r & 15)];
#pragma unroll 1
            for (int i = 0; i < SEQ / 64 + 2; ++i) {
                if (i >= 2) {
                    const int ch = i - 2; const LAS bf16* src = hs + (ch & 1) * 64 * HS; const int m0 = b * SEQ + ch * 64 + 32 * tt;
                    float uv[16];
#pragma unroll
                    for (int q = 0; q < 16; ++q) uv[q] = bf2f(un[q]);
                    if (ch + 1 < SEQ / 64) {
#pragma unroll
                        for (int q = 0; q < 16; ++q) un[q] = U[(size_t)(m0 + 64 + crow(q, h)) * S5_WIDTH + g * 16 + (r & 15)];
                    }
                    bf16x8v hf[8];
#pragma unroll
                    for (int kk = 0; kk < 8; ++kk) hf[kk] = row_frag(src, HS, 32 * tt + r, 16 * kk + 8 * h);
                    __builtin_amdgcn_sched_barrier(0);
                    f32x16 y;
#pragma unroll
                    for (int q = 0; q < 16; ++q) y[q] = 0.f;
#pragma unroll
                    for (int kk = 0; kk < 8; ++kk) y = MFMA32(hf[kk], Cf[kk], y);
                    if (r < 16) {
#pragma unroll
                        for (int q = 0; q < 16; ++q) G[(size_t)(m0 + crow(q, h)) * S5_WIDTH + g * 16 + r] = (bf16)(pkbf(gelu_tanh(y[q] + dsk * uv[q]), 0.f) & 0xffffu);
                    }
                }
                LDS_BARRIER();
            }
        } else {
#pragma unroll 1
            for (int i = 0; i < SEQ / 64 + 2; ++i) LDS_BARRIER();
        }
    }
    LDS_BARRIER();
}

struct CvtItem { const float* src; bf16* dst; const float* g; int N, K, il, off, tiled, kb; };
__device__ __forceinline__ void cvt_load(f32x4 (&v)[16], float (&gk)[16], const CvtItem& it, int lane) {
    const float* p = it.src + (size_t)(lane >> 4) * it.N + 4 * (lane & 15);
#pragma unroll
    for (int i = 0; i < 16; ++i) v[i] = *(const f32x4*)(p + (size_t)(4 * i) * it.N);
    if (it.g) {
#pragma unroll
        for (int i = 0; i < 16; ++i) gk[i] = it.g[4 * i + (lane >> 4)];
    } else {
#pragma unroll
        for (int i = 0; i < 16; ++i) gk[i] = 1.0f;
    }
}
__device__ __forceinline__ void cvt_process(const f32x4 (&v)[16], const float (&gk)[16], const CvtItem& it, int n0, LAS bf16* T1, LAS bf16* T2, int lane, int nostore = 0) {
    constexpr int TS = 72;
#pragma unroll
    for (int i = 0; i < 16; ++i) { v2u w; w.x = pkbf(v[i].x * gk[i], v[i].y * gk[i]); w.y = pkbf(v[i].z * gk[i], v[i].w * gk[i]); *(LAS v2u*)(T1 + (4 * i + (lane >> 4)) * TS + 4 * (lane & 15)) = w; }
    const int i16 = lane & 15, q = i16 >> 2, pp = i16 & 3, g = lane >> 4;
#pragma unroll
    for (int c = 0; c < 8; ++c) {
        const s16x4v lo = __builtin_amdgcn_ds_read_tr16_b64_v4i16((LAS s16x4v*)(T1 + (8 * c + q) * TS + 16 * g + 4 * pp));
        const s16x4v hi = __builtin_amdgcn_ds_read_tr16_b64_v4i16((LAS s16x4v*)(T1 + (8 * c + 4 + q) * TS + 16 * g + 4 * pp));
        *(LAS bf16x8v*)(T2 + lane * TS + 8 * c) = __builtin_shufflevector(lo, hi, 0, 1, 2, 3, 4, 5, 6, 7);
    }
#pragma unroll
    for (int t = 0; t < 8; ++t) { const int n = 8 * t + (lane >> 3), c = lane & 7; const v4u o = *(const LAS v4u*)(T2 + n * TS + 8 * c);
        const int nn = n0 + n; const int row = it.il ? ((nn >> 7) * 256 + (nn & 127) + it.off) : nn;
        bf16* p = it.tiled ? it.dst + ((size_t)((row >> 8) * (it.K >> 6) + it.kb) * 256 + (row & 255)) * 64 + 8 * c
                           : it.dst + (size_t)row * it.K + 64 * it.kb + 8 * c;
        if (!nostore || o.x == 0x12345678u) *(v4u*)p = o; }
}
__device__ __forceinline__ void ph_convert(const CAS Params* PP, int L, unsigned char* Wb, LAS unsigned char* lds, int gw, int NGW, int lane, int wave, int nostore = 0) {
    LAS bf16* T1 = (LAS bf16*)(lds + wave * 18432); LAS bf16* T2 = T1 + 64 * 72;
    const size_t fo = (size_t)L * D_MODEL * D_FF; const int eo = L >> 1; const bool even = (L & 1) == 0;
    constexpr int NF = 2816;
    const int n_mix = even ? (1280 + 256 + 1024) : (5152 + 2048);
    const int total = 6 * NF + n_mix;
    auto pick = [&](int idx, CvtItem& d, int& n0) {
        const float* W; bf16* WT; const float* gv = nullptr; int K, N, il = 0, off = 0, rel, tiled = 1;
        if (idx < 6 * NF) { const int mi = idx / NF; rel = idx - mi * NF;
            const int which = mi / 3, t = mi - 3 * which;
            if (t == 2) { W = (const float*)(const GAS float*)PP->in[which ? I_F2D : I_F1D] + fo; WT = (bf16*)(Wb + (which ? W_D1 : W_D0)); K = D_FF; N = D_MODEL; tiled = 1; }
            else { W = (const float*)(const GAS float*)PP->in[which ? (t ? I_F2U : I_F2G) : (t ? I_F1U : I_F1G)] + fo; WT = (bf16*)(Wb + (which ? W_GU1 : W_GU0)); K = D_MODEL; N = D_FF; il = 1; off = t ? 128 : 0;
                   gv = (const float*)(const GAS float*)PP->in[which ? I_NFFN2 : I_NFFN1] + (size_t)L * D_MODEL; }
        } else { rel = idx - 6 * NF;
            if (even) {
                if (rel < 1280) { W = (const float*)(const GAS float*)PP->in[I_EWIN] + (size_t)eo * D_MODEL * EVEN_IN; WT = (bf16*)(Wb + W_EIN); K = D_MODEL; N = EVEN_IN; gv = (const float*)(const GAS float*)PP->in[I_NMIX] + (size_t)L * D_MODEL; }
                else if (rel < 1280 + 256) { rel -= 1280; W = (const float*)(const GAS float*)PP->in[I_WGLU] + (size_t)eo * 1024 * 1024; WT = (bf16*)(Wb + W_EGLU); K = 1024; N = 1024; }
                else { rel -= 1280 + 256; W = (const float*)(const GAS float*)PP->in[I_EWOUT] + (size_t)eo * 2048 * 2048; WT = (bf16*)(Wb + W_EOUT); K = 2048; N = 2048; }
            } else {
                if (rel < 5152) { W = (const float*)(const GAS float*)PP->in[I_MWIN] + (size_t)eo * D_MODEL * M_IN; WT = (bf16*)(Wb + W_OIN); K = D_MODEL; N = M_IN; gv = (const float*)(const GAS float*)PP->in[I_NMIX] + (size_t)L * D_MODEL; }
                else { rel -= 5152; W = (const float*)(const GAS float*)PP->in[I_MWOUT] + (size_t)eo * M_INNER * D_MODEL; WT = (bf16*)(Wb + W_OOUT); K = M_INNER; N = D_MODEL; gv = (const float*)(const GAS float*)PP->in[I_MNORM] + (size_t)eo * M_INNER; }
            }
        }
        const int nblk = N >> 6, kb = rel / nblk, nb = rel - kb * nblk;
        d.src = W + (size_t)(64 * kb) * N + 64 * nb; d.dst = WT; d.tiled = tiled; d.kb = kb; d.N = N; d.K = K; d.il = il; d.off = off; d.g = gv ? gv + 64 * kb : nullptr; n0 = 64 * nb;
    };
    f32x4 va[16], vb[16]; float ga[16], gb[16]; CvtItem da, db; int na = 0, nbn = 0;
    int idx = gw;
    if (idx < total) { pick(idx, da, na); cvt_load(va, ga, da, lane); }
    while (idx < total) {
        const int i1 = idx + NGW, i2 = idx + 2 * NGW;
        if (i1 < total) { pick(i1, db, nbn); cvt_load(vb, gb, db, lane); }
        cvt_process(va, ga, da, na, T1, T2, lane, nostore);
        if (i1 < total) {
            if (i2 < total) { pick(i2, da, na); cvt_load(va, ga, da, lane); }
            cvt_process(vb, gb, db, nbn, T1, T2, lane, nostore);
        }
        idx = i2;
    }
}

__device__ __forceinline__ void ph_dt_mini(const bf16* XB, const bf16* Wdt, const float* SS, float* DT, LAS unsigned char* lds, int bid, int nblk, int tid_in) {
    constexpr int PS = 68;
    LAS float* part = (LAS float*)lds;
    int tid = tid_in;
    const int lane = tid & 63, wave = __builtin_amdgcn_readfirstlane(tid >> 6), r = lane & 31, h = lane >> 5;
    for (int job = bid; job < M_TOK / 64; job += nblk) {
        const int R0 = job * 64;
        const bf16* ap = XB + ((size_t)((R0 >> 8) * 32) * 256 + (R0 & 255) + r) * 64 + 8 * h;
        const bf16* bp = Wdt + (size_t)r * 64 + 8 * h;
        f32x16 acc[2][2];
#pragma unroll
        for (int i = 0; i < 16; ++i) { acc[0][0][i] = 0.f; acc[0][1][i] = 0.f; acc[1][0][i] = 0.f; acc[1][1][i] = 0.f; }
#pragma unroll 1
        for (int q = 0; q < 4; ++q) { const size_t ko = (size_t)(4 * wave + q) * 16384;
            bf16x8v af[4][2], bf[4][2];
#pragma unroll
            for (int ks = 0; ks < 4; ++ks)
#pragma unroll
                for (int t = 0; t < 2; ++t) { af[ks][t] = *(const bf16x8v*)(ap + ko + t * 2048 + ks * 16); bf[ks][t] = *(const bf16x8v*)(bp + ko + t * 2048 + ks * 16); }
#pragma unroll
            for (int ks = 0; ks < 4; ++ks)
#pragma unroll
                for (int rt = 0; rt < 2; ++rt)
#pragma unroll
                    for (int ct = 0; ct < 2; ++ct) acc[rt][ct] = MFMA32(af[ks][rt], bf[ks][ct], acc[rt][ct]);
        }
        LDS_BARRIER();
#pragma unroll
        for (int rt = 0; rt < 2; ++rt)
#pragma unroll
            for (int ct = 0; ct < 2; ++ct)
#pragma unroll
                for (int i = 0; i < 16; ++i) part[(wave * 64 + 32 * rt + crow(i, h)) * PS + 32 * ct + r] = acc[rt][ct][i];
        LDS_BARRIER();
        { const int row = tid >> 3, c8 = (tid & 7) * 8; f32x4 s0 = *(const LAS f32x4*)(part + row * PS + c8), s1 = *(const LAS f32x4*)(part + row * PS + c8 + 4);
#pragma unroll
          for (int w = 1; w < 8; ++w) { s0 += *(const LAS f32x4*)(part + (w * 64 + row) * PS + c8); s1 += *(const LAS f32x4*)(part + (w * 64 + row) * PS + c8 + 4); }
          const f32x4 sp = *(const f32x4*)(SS + (size_t)(R0 + row) * 32 + 4 * (tid & 7)); float t = (sp[0] + sp[1]) + (sp[2] + sp[3]);
          t += __shfl_xor(t, 1); t += __shfl_xor(t, 2); t += __shfl_xor(t, 4);
          const float sc = __builtin_amdgcn_rsqf(t * (1.0f / 2048.0f) + 1e-5f);
          float* op = DT + (size_t)(R0 + row) * 64 + c8; *(f32x4*)op = s0 * sc; *(f32x4*)(op + 4) = s1 * sc; }
    }
    LDS_BARRIER();
}
constexpr int NPH = 37 + 8 * ((PROBE_MASK >> 3) & 1) + 8 * ((PROBE_MASK >> 4) & 1) + 4 * ((PROBE_MASK >> 5) & 1) + 6 * ((PROBE_MASK >> 8) & 1) + 40 * ((PROBE_MASK >> 18) & 1);
__global__ void __launch_bounds__(512, 2) k_fwd(Params P) {
    extern __shared__ __attribute__((aligned(16))) unsigned char lds_raw[];
    LAS unsigned char* lds = (LAS unsigned char*)lds_raw;
    unsigned char* ws = P.ws;
    volatile LAS unsigned* MISC = (volatile LAS unsigned*)(lds + MISC_OFF);
    const int WV = __builtin_amdgcn_readfirstlane((int)threadIdx.x >> 6);
    if (threadIdx.x < 16) MISC[threadIdx.x] = 0u;
    __syncthreads();
    XcdBarrier bar; bar.bar = (unsigned*)(ws + WS_CTL) + CW_BAR; bar.x = 0; bar.st = MISC; bar.lead = false;
    if (P.hi - P.lo > 1) bar = xcd_barrier_post((unsigned*)(ws + WS_CTL) + CW_BAR, MISC);
    int ph = 0;
#define PH_BEGIN if (ph >= P.lo && ph < P.hi) { unsigned ones = ~0u; asm volatile("" : "+s"(ones)); int tid = WV * 64 + (int)__builtin_amdgcn_mbcnt_hi(ones, __builtin_amdgcn_mbcnt_lo(ones, 0u)); int bid = blockIdx.x, G = gridDim.x; asm volatile("" : "+s"(bid), "+s"(G)); \
    const int lane = tid & 63, wave = __builtin_amdgcn_readfirstlane(tid >> 6), gw = bid * 8 + wave, gtid = bid * 512 + tid, NGW = G * 8, gthreads = G * 512; (void)lane; (void)gw; (void)gtid; (void)NGW; (void)gthreads; \
    const CAS Params* PP = (const CAS Params*)__builtin_amdgcn_kernarg_segment_ptr(); asm volatile("" : "+s"(PP)); unsigned char* ws = (unsigned char*)(GAS unsigned char*)PP->ws; \
    float* X = (float*)(ws + WS_X); bf16* XN = (bf16*)(ws + WS_XN); float* ROT = (float*)(ws + WS_ROT); unsigned char* R = ws + WS_R; unsigned char* Wb = ws + WS_W; float* SSb = (float*)(ws + WS_SS); (void)SSb; float* SSGb = (float*)(ws + WS_SSG); (void)SSGb; float* DUMMY = (float*)(ws + WS_END); (void)X; (void)XN; (void)ROT; (void)R; (void)Wb; (void)DUMMY;
#define PH_END   if (ph + 1 < P.hi) { XcdBarrier bb = bar; unsigned boff = CW_BAR; asm volatile("" : "+s"(boff)); bb.bar = (unsigned*)(P.ws + WS_CTL) + boff; unsigned on2 = ~0u; asm volatile("" : "+s"(on2)); bb.lead = (WV == 0) && (__builtin_amdgcn_mbcnt_hi(on2, __builtin_amdgcn_mbcnt_lo(on2, 0u)) == 0u); xcd_barrier(bb); } } ++ph;
#define REP_BEGIN(kind) for (int rep = ((PROBE_MASK >> (kind)) & 1) ? 0 : 1; rep < 2; ++rep) {
#define REP_END }
#define INF(i) ((const float*)(const GAS float*)PP->in[i])
#define OUTP ((float*)(GAS float*)PP->out)

#define Qb ((bf16*)(R + R_Q))
#define Kb ((bf16*)(R + R_K))
#define Vb ((bf16*)(R + R_V))
#define Ub ((bf16*)(R + R_U))
#define Gb ((bf16*)(R + R_G))
#define CATb ((bf16*)(R + R_CAT))
#define Zb ((bf16*)(R + R_Z))
#define XBCb ((bf16*)(R + R_XBC))
#define XBCCb ((bf16*)(R + R_XBCC))
#define YGb ((bf16*)(R + R_YG))
#define YNb ((bf16*)(R + R_YN))
#define DTb ((float*)(R + R_DT))

#pragma unroll 1
    for (int fi = 0; fi < 2 * DEPTH; ++fi) {
        const int L = fi >> 1, which = fi & 1;
        if (which == 0) {
            PH_BEGIN
                if (L == 0) {
                    const int* pos = (const int*)(const GAS int*)PP->in[I_POS];
                    for (int i = gtid; i < M_TOK * 8; i += gthreads) { const int m = i >> 3, j = i & 7; float a = -13.122363377404328f * (float)j; a = a * 0.125f; const float ang = (float)pos[m] * expf(a);
                        ROT[m * 16 + j] = cosf(ang); ROT[m * 16 + 8 + j] = sinf(ang); }
                    ph_xb_ss(INF(I_X), XN, SSb, gw, NGW, lane);
                }
                REP_BEGIN(1)
                ph_convert(PP, L, Wb, lds, gw, NGW, lane, wave, (PROBE_MASK & 0x10000) ? (rep == 0) : 0);
                if ((L & 1) == 1) {
                    { unsigned z0 = 0u; asm volatile("" : "+v"(z0));
                      for (int i = gtid; i < 32 * 1536; i += gthreads) { const int kt = i / 1536, w16 = i - kt * 1536;
                          *(v4u*)(Wb + W_OIN + ((size_t)(40 * 32 + kt) * 256 + 64) * 128 + (size_t)w16 * 16) = (v4u){z0, z0, z0, z0}; } }
                }
            REP_END PH_END
        }
#define xsrc ((fi == 0) ? INF(I_X) : (const float*)X)
#if (PROBE_MASK >> 3) & 1
        PH_BEGIN { constexpr int rep = 0;
            pg8::Gemm g{XN, (const bf16*)(Wb + (which ? W_GU1 : W_GU0)), M_TOK, 2 * D_FF, D_MODEL}; pg8::StaticOrder S; S.init(M_TOK, 2 * D_FF, G, bid);
            pg8::stage_row_scales(lds, SSb, S, tid);
            pg8::EpiSwiGLU E{(bf16*)(R + R_H), D_FF, lds};
            pg8::gemm_phase<pg8::EpiSwiGLU, pg8::StaticOrder, true, true, true, true>(lds, g, S, E, tid);
        } PH_END
#endif
        PH_BEGIN { constexpr int rep = 1; (void)rep;
            pg8::Gemm g{XN, (const bf16*)(Wb + (which ? W_GU1 : W_GU0)), M_TOK, 2 * D_FF, D_MODEL}; pg8::StaticOrder S; S.init(M_TOK, 2 * D_FF, G, bid);
            pg8::stage_row_scales(lds, SSb, S, tid);
            pg8::EpiSwiGLU E{(bf16*)(R + R_H), D_FF, lds};
            pg8::gemm_phase<pg8::EpiSwiGLU, pg8::StaticOrder, true, true, true, true>(lds, g, S, E, tid);
        } PH_END
#if (PROBE_MASK >> 4) & 1
        PH_BEGIN { constexpr int rep = 0;
            pg8::Gemm g{(const bf16*)(R + R_H), (const bf16*)(Wb + (which ? W_D1 : W_D0)), M_TOK, D_MODEL, D_FF}; pg8::MaskOrder S; S.init(M_TOK, D_MODEL, G, bid, 4); S.mask = (PROBE_MASK & 0x20000) ? 7 : 63;
            pg8::EpiResid E{XN, (bf16*)DUMMY, DUMMY + (size_t)M_TOK * D_MODEL, D_MODEL, 1, lds};
            pg8::gemm_phase<pg8::EpiResid, pg8::MaskOrder, true, true, true, true>(lds, g, S, E, tid);
        } PH_END
#endif
        PH_BEGIN { constexpr int rep = 1; (void)rep;
            pg8::Gemm g{(const bf16*)(R + R_H), (const bf16*)(Wb + (which ? W_D1 : W_D0)), M_TOK, D_MODEL, D_FF}; pg8::StaticOrder S; S.init(M_TOK, D_MODEL, G, bid, 4);
            pg8::EpiResid E{XN, rep ? XN : (bf16*)DUMMY, rep ? SSb : DUMMY + (size_t)M_TOK * D_MODEL, D_MODEL, 1, lds};
            pg8::gemm_phase<pg8::EpiResid, pg8::StaticOrder, true, true, true, true>(lds, g, S, E, tid);
        } PH_END
        if (which == 0) {
            const int eo = L >> 1;
            if ((L & 1) == 0) {
#if (PROBE_MASK >> 5) & 1
                PH_BEGIN { constexpr int rep = 0;
                    pg8::Gemm g{XN, (const bf16*)(Wb + W_EIN), M_TOK, EVEN_IN, D_MODEL}; pg8::StaticOrder S; S.init(M_TOK, EVEN_IN, G, bid);
                    pg8::stage_row_scales(lds, SSb, S, tid);
                    pg8::EpiEvenIn E{Qb, Kb, Vb, Ub, ROT, lds};
                    pg8::gemm_phase<pg8::EpiEvenIn, pg8::StaticOrder, true, true, true, true>(lds, g, S, E, tid);
                } PH_END
#endif
                PH_BEGIN { constexpr int rep = 1; (void)rep;
                    pg8::Gemm g{XN, (const bf16*)(Wb + W_EIN), M_TOK, EVEN_IN, D_MODEL}; pg8::StaticOrder S; S.init(M_TOK, EVEN_IN, G, bid);
                    pg8::stage_row_scales(lds, SSb, S, tid);
                    pg8::EpiEvenIn E{Qb, Kb, Vb, Ub, ROT, lds};
                    pg8::gemm_phase<pg8::EpiEvenIn, pg8::StaticOrder, true, true, true, true>(lds, g, S, E, tid);
                } PH_END
                PH_BEGIN
                REP_BEGIN(6)
                    ph_attn_mfma(Qb, Kb, Vb, INF(I_SINK) + eo * A_HEADS, CATb, lds, bid, G, tid);
                REP_END
                REP_BEGIN(10)
                    ph_s5_mfma(PP, eo, Ub, Gb, lds, bid, G, tid);
                REP_END
                PH_END
#if (PROBE_MASK >> 8) & 1
                PH_BEGIN { constexpr int rep = 0;
                    pg8::Gemm g{Gb, (const bf16*)(Wb + W_EGLU), M_TOK, 1024, 1024}; pg8::StaticOrder S; S.init(M_TOK, 1024, G, bid);
                    pg8::EpiGLU E{Gb, INF(I_BGLU) + (size_t)eo * 1024, CATb};
                    pg8::gemm_phase<pg8::EpiGLU, pg8::StaticOrder, true, true, false, true>(lds, g, S, E, tid);
                } PH_END
#endif
                PH_BEGIN { constexpr int rep = 1; (void)rep;
                    pg8::Gemm g{Gb, (const bf16*)(Wb + W_EGLU), M_TOK, 1024, 1024}; pg8::StaticOrder S; S.init(M_TOK, 1024, G, bid);
                    pg8::EpiGLU E{Gb, INF(I_BGLU) + (size_t)eo * 1024, CATb};
                    pg8::gemm_phase<pg8::EpiGLU, pg8::StaticOrder, true, true, false, true>(lds, g, S, E, tid);
                } PH_END
#if (PROBE_MASK >> 8) & 1
                PH_BEGIN { constexpr int rep = 0;
                    pg8::Gemm g{CATb, (const bf16*)(Wb + W_EOUT), M_TOK, D_MODEL, 2048}; pg8::StaticOrder S; S.init(M_TOK, D_MODEL, G, bid, 4);
                    pg8::EpiResid E{XN, rep ? XN : (bf16*)DUMMY, rep ? SSb : DUMMY + (size_t)M_TOK * D_MODEL, D_MODEL, 0, lds};
                    pg8::gemm_phase<pg8::EpiResid, pg8::StaticOrder, true, true, false, true>(lds, g, S, E, tid);
                } PH_END
#endif
                PH_BEGIN { constexpr int rep = 1; (void)rep;
                    pg8::Gemm g{CATb, (const bf16*)(Wb + W_EOUT), M_TOK, D_MODEL, 2048}; pg8::StaticOrder S; S.init(M_TOK, D_MODEL, G, bid, 4);
                    pg8::EpiResid E{XN, rep ? XN : (bf16*)DUMMY, rep ? SSb : DUMMY + (size_t)M_TOK * D_MODEL, D_MODEL, 0, lds};
                    pg8::gemm_phase<pg8::EpiResid, pg8::StaticOrder, true, true, false, true>(lds, g, S, E, tid);
                } PH_END
            } else {
#if (PROBE_MASK >> 5) & 1
                PH_BEGIN { constexpr int rep = 0;
                    pg8::Gemm g{XN, (const bf16*)(Wb + W_OIN), M_TOK, M_IN_PAD, D_MODEL}; pg8::StaticOrder S; S.init(M_TOK, M_IN_PAD, G, bid);
                    pg8::stage_row_scales(lds, SSb, S, tid);
                    pg8::EpiOddIn E{Zb, XBCb, DTb, lds};
                    pg8::gemm_phase<pg8::EpiOddIn, pg8::StaticOrder, true, true, true, true>(lds, g, S, E, tid);
                } PH_END
#endif
                PH_BEGIN { constexpr int rep = 1; (void)rep;
                    ph_dt_mini(XN, (const bf16*)(Wb + W_OIN) + (size_t)40 * 32 * 16384, SSb, DTb, lds, bid, G, tid);
                    pg8::Gemm g{XN, (const bf16*)(Wb + W_OIN), M_TOK, 40 * 256, D_MODEL}; pg8::StaticOrder S; S.init(M_TOK, 40 * 256, G, bid);
                    pg8::stage_row_scales(lds, SSb, S, tid);
                    pg8::EpiOddIn E{Zb, XBCb, DTb, lds};
                    pg8::gemm_phase<pg8::EpiOddIn, pg8::StaticOrder, true, true, true, true>(lds, g, S, E, tid);
                } PH_END
                PH_BEGIN REP_BEGIN(7)
                    ph_conv(rep,XBCb, INF(I_CONVW) + (size_t)eo * 4 * M_CONV_DIM, INF(I_CONVB) + (size_t)eo * M_CONV_DIM, INF(I_DTB) + eo * 64, XBCCb, DTb, gw, NGW, lane, gtid, gthreads);
                REP_END PH_END
                PH_BEGIN REP_BEGIN(9)
#if USE_MFMA_SSD
                    ph_ssd_mfma(XBCCb, DTb, Zb, INF(I_ALOG) + eo * 64, INF(I_MD) + eo * 64, YGb, SSGb, lds, bid, G, tid);
#else
                    ph_ssd_naive(XBCCb, DTb, Zb, INF(I_ALOG) + eo * 64, INF(I_MD) + eo * 64, YGb, SSGb, lds, bid, G, tid);
#endif
                REP_END PH_END
#if (PROBE_MASK >> 8) & 1
                PH_BEGIN { constexpr int rep = 0;
                    pg8::Gemm g{YGb, (const bf16*)(Wb + W_OOUT), M_TOK, D_MODEL, M_INNER}; pg8::StaticOrder S; S.init(M_TOK, D_MODEL, G, bid, 4);
                    pg8::stage_group_scales(lds, SSGb, S, tid);
                    pg8::EpiResid E{XN, rep ? XN : (bf16*)DUMMY, rep ? SSb : DUMMY + (size_t)M_TOK * D_MODEL, D_MODEL, 2, lds};
                    pg8::gemm_phase<pg8::EpiResid, pg8::StaticOrder, true, true, true, true, true>(lds, g, S, E, tid);
                } PH_END
#endif
                PH_BEGIN { constexpr int rep = 1; (void)rep;
                    pg8::Gemm g{YGb, (const bf16*)(Wb + W_OOUT), M_TOK, D_MODEL, M_INNER}; pg8::StaticOrder S; S.init(M_TOK, D_MODEL, G, bid, 4);
                    pg8::stage_group_scales(lds, SSGb, S, tid);
                    pg8::EpiResid E{XN, rep ? XN : (bf16*)DUMMY, rep ? SSb : DUMMY + (size_t)M_TOK * D_MODEL, D_MODEL, 2, lds};
                    pg8::gemm_phase<pg8::EpiResid, pg8::StaticOrder, true, true, true, true, true>(lds, g, S, E, tid);
                } PH_END
            }
        }
    }
#if PROBE_MASK & 0x40000
    for (int e = 0; e < 40; ++e) { PH_BEGIN PH_END }
#endif
    PH_BEGIN REP_BEGIN(2)
        ph_rmsnorm_out(XN, INF(I_FNORM), OUTP, gw, NGW, lane);
    REP_END PH_END
#undef PH_BEGIN
#undef PH_END
}

extern "C" void kernel_launch(void* const* d_in, const int* in_sizes, int n_in, void* d_out, int out_size, void* d_ws, size_t ws_size, hipStream_t stream) {
    static int grid = 0;
    if (grid == 0) {
        if (n_in != 33 || in_sizes[0] != M_TOK * D_MODEL || out_size != M_TOK * D_MODEL || ws_size < WS_END) { fprintf(stderr, "kernel_launch: unexpected shapes (n_in %d, ws %zu < %zu?)\n", n_in, ws_size, (size_t)WS_END); grid = -1; return; }
        int dev = 0, cus = 0;
        if (hipGetDevice(&dev) != hipSuccess || hipDeviceGetAttribute(&cus, hipDeviceAttributeMultiprocessorCount, dev) != hipSuccess) { grid = -1; return; }
        if (hipFuncSetAttribute((const void*)k_fwd, hipFuncAttributeMaxDynamicSharedMemorySize, LDS_BYTES) != hipSuccess) { fprintf(stderr, "kernel_launch: hipFuncSetAttribute failed\n"); grid = -1; return; }
        int per_cu = 0;
        if (hipOccupancyMaxActiveBlocksPerMultiprocessor(&per_cu, (const void*)k_fwd, 512, LDS_BYTES) != hipSuccess || per_cu < 1) fprintf(stderr, "kernel_launch: occupancy query reports %d\n", per_cu);
        (void)hipGetLastError();
        grid = cus;
    }
    if (grid < 0) return;
    (void)hipMemsetAsync((char*)d_ws + WS_CTL, 0, CTL_ZERO_BYTES, stream);
    Params p{};
    for (int i = 0; i < 33; ++i) p.in[i] = d_in[i];
    p.out = (float*)d_out; p.ws = (unsigned char*)d_ws;
#if MK_ONE_LAUNCH
    p.lo = 0; p.hi = NPH;
    hipLaunchKernelGGL(k_fwd, dim3(grid), dim3(512), LDS_BYTES, stream, p);
#else
    for (int ph = 0; ph < NPH; ++ph) { p.lo = ph; p.hi = ph + 1; hipLaunchKernelGGL(k_fwd, dim3(grid), dim3(512), LDS_BYTES, stream, p); }
#endif
}
```

```cpp
#include <hip/hip_runtime.h>
#include <cstdio>
#include <cstdint>

#ifndef MK_ONE_LAUNCH
#define MK_ONE_LAUNCH 1
#endif

#ifndef PROBE_MASK
#define PROBE_MASK 0
#endif
#ifndef USE_MFMA_ATTN
#define USE_MFMA_ATTN 1
#endif
#ifndef USE_MFMA_S5
#define USE_MFMA_S5 1
#endif
#ifndef USE_MFMA_SSD
#define USE_MFMA_SSD 1
#endif

constexpr int D_MODEL = 2048, BATCH = 4, SEQ = 4096, DEPTH = 4, M_TOK = BATCH * SEQ;
constexpr int D_FF = 5632;
constexpr float NORM_EPS = 1e-5f;
constexpr int A_HEADS = 16, A_KV = 4, HD = 64, WINDOW = 128;
constexpr int A_WIDTH = 1024, KV_WIDTH = 256, S5_WIDTH = 1024, S5_GROUP = 16, S5_GROUPS = 64, S5_STATE = 64;
constexpr int EVEN_IN = 2560;
constexpr int M_INNER = 4096, M_HEADS = 64, M_GROUPS = 8, M_STATE = 128, M_CONV_DIM = 6144, M_IN = 10304, M_IN_PAD = 10496;

namespace pg8 {
#define PG8_LAS __attribute__((address_space(3)))
typedef unsigned short bf16_t;
typedef short bf16x8 __attribute__((ext_vector_type(8)));
typedef float f32x4 __attribute__((ext_vector_type(4)));
typedef unsigned u32x4 __attribute__((ext_vector_type(4)));
constexpr int BM = 256, BK = 64, HALF = 128, HTB = HALF * BK * 2  , STAGE_BYTES = 8 * HTB, NXCD = 8, WGM = 8;

__host__ __device__ __forceinline__ int lds_byte(int r, int c) { const int st = (r >> 4) * 2 + (c >> 5), rr = r & 15, cc = c & 31, ob = rr * 64 + cc * 2; return st * 1024 + (ob ^ (((ob >> 9) & 1) << 5)); }
__host__ __device__ __forceinline__ void stage_rc(int b, int& R, int& C) { const int st = b / 1024, sb = b % 1024, swz = sb ^ (((sb >> 9) & 1) << 5); R = (st >> 1) * 16 + swz / 64; C = (st & 1) * 32 + (swz % 64) / 2; }
__host__ __device__ __forceinline__ int perm32(int rho) { const int n = rho >> 4, i = rho & 15; return 8 * (i >> 2) + 4 * n + (i & 3); }

struct Unit { int pm, pn, ui; };
struct Gemm { const bf16_t* A; const bf16_t* Bt; int M, N, K; };

struct StaticOrder {
    int nM, nN, nwg, G, c, wgm;
    __host__ __device__ void init(int M, int N, int G_, int c_, int wgm_ = WGM) { nM = M / BM; nN = N / BM; nwg = nM * nN; G = G_; c = c_; wgm = wgm_; }
    __host__ __device__ bool next(int i, Unit& u) const {
        const long L = (long)i * G + c; if (L >= nwg) return false;
        int wgid = (int)L; { const int q = nwg / NXCD, r = nwg % NXCD, xcd = wgid % NXCD, off = wgid / NXCD; wgid = (xcd < r ? xcd * (q + 1) : r * (q + 1) + (xcd - r) * q) + off; }
        const int nig = wgm * nN, gid = wgid / nig, fm = gid * wgm, gsz = (nM - fm) < wgm ? (nM - fm) : wgm;
        u.pm = fm + ((wgid % nig) % gsz); u.pn = (wgid % nig) / gsz; return true;
    }
    __device__ __forceinline__ void a_ready(const Unit&) const {}
    __device__ __forceinline__ void done(const Unit&) const {}
};

struct MaskOrder : StaticOrder { int mask; __host__ __device__ bool next(int i, Unit& u) const { const bool ok = StaticOrder::next(i, u); u.pm &= mask; return ok; } };
__device__ __forceinline__ unsigned cvt_pk_bf16(float lo, float hi) { unsigned r; asm volatile("v_cvt_pk_bf16_f32 %0, %1, %2" : "=v"(r) : "v"(lo), "v"(hi)); return r; }
__device__ __forceinline__ void store16_sc1(void* p, u32x4 v) { asm volatile("global_store_dwordx4 %0, %1, off sc1\n\ts_nop 1" :: "v"(p), "v"(v) : "memory"); }
__device__ __forceinline__ float bf_lo(unsigned w) { return __uint_as_float(w << 16); }
__device__ __forceinline__ float bf_hi(unsigned w) { return __uint_as_float(w & 0xffff0000u); }
__device__ __forceinline__ float fast_sigmoid(float x) { return __builtin_amdgcn_rcpf(1.0f + __expf(-x)); }
__device__ __forceinline__ f32x4 shfl_xor4(f32x4 v, int mask) { f32x4 r; r[0] = __shfl_xor(v[0], mask); r[1] = __shfl_xor(v[1], mask); r[2] = __shfl_xor(v[2], mask); r[3] = __shfl_xor(v[3], mask); return r; }

constexpr int GS_LDS_OFF = 131072;
constexpr int RS_LDS_OFF = 131072;
template <class Sched> __device__ __forceinline__ void stage_row_scales(PG8_LAS unsigned char* lds, const float* SS, const Sched& S, int tid) {
    PG8_LAS float* sl = (PG8_LAS float*)(lds + RS_LDS_OFF);
    Unit u;
    int prev_pm = -1; float val = 0.f;
    for (int i = 0; i < 12 && S.next(i, u); ++i) {
        if (tid < 256) {
            if (u.pm != prev_pm) { const f32x4* p = (const f32x4*)(SS + (size_t)(u.pm * BM + tid) * 32); float t = 0.f;
#pragma unroll
                for (int k = 0; k < 8; ++k) { const f32x4 a = p[k]; t += (a[0] + a[1]) + (a[2] + a[3]); }
                val = __builtin_amdgcn_rsqf(t * (1.0f / 2048.0f) + 1e-5f); }
            sl[i * 256 + tid] = val; }
        prev_pm = u.pm;
    }
    __syncthreads();
}
template <class Sched> __device__ __forceinline__ void stage_group_scales(PG8_LAS unsigned char* lds, const float* SSG, const Sched& S, int tid) {
    PG8_LAS float* gt = (PG8_LAS float*)(lds + GS_LDS_OFF);
    Unit u;
    for (int i = 0; i < 4 && S.next(i, u); ++i) {
        if (tid < 256) { const f32x4* p = (const f32x4*)(SSG + (size_t)(u.pm * BM + tid) * 64); float s[8]; f32x4 q[16];
#pragma unroll
            for (int g = 0; g < 16; ++g) q[g] = p[g];
            __builtin_amdgcn_sched_barrier(0);
#pragma unroll
            for (int g = 0; g < 8; ++g) { const f32x4 a = q[2 * g], c = q[2 * g + 1]; s[g] = __builtin_amdgcn_rsqf((((a[0] + a[1]) + (a[2] + a[3])) + ((c[0] + c[1]) + (c[2] + c[3]))) * (1.0f / 512.0f) + 1e-5f); }
#pragma unroll
            for (int g = 0; g < 7; ++g) gt[(i * 256 + tid) * 8 + g] = s[g] * __builtin_amdgcn_rcpf(s[g + 1]);
            gt[(i * 256 + tid) * 8 + 7] = s[7]; }
    }
    __syncthreads();
}
__device__ __forceinline__ void row_scales(PG8_LAS unsigned char* lds, const Unit& u, int wr, int fr, float (&s)[8]) {
    const PG8_LAS float* sl = (const PG8_LAS float*)(lds + RS_LDS_OFF) + u.ui * 256 + wr * 64 + fr;
#pragma unroll
    for (int i = 0; i < 8; ++i) s[i] = sl[(i >> 2) * HALF + (i & 3) * 16];
}


struct EpiSwiGLU {
    static constexpr bool PERM = true, AFTER_DRAIN = false;
    bf16_t* H; int ldc; PG8_LAS unsigned char* lds;
    __device__ __forceinline__ void operator()(const f32x4 (&acc)[2][2][4][2], const Unit& u, int wr, int wc, int fr, int fq) const {
        float rs[8]; row_scales(lds, u, wr, fr, rs);
#pragma unroll
        for (int ai = 0; ai < 2; ++ai)
#pragma unroll
            for (int m = 0; m < 4; ++m) {
                bf16_t* rowp = H + ((size_t)(u.pm * (ldc >> 6) + u.pn * 2 + (wc >> 1)) * BM + (wr * 64 + fr + ai * HALF + m * 16)) * 64 + (wc & 1) * 32 + 8 * fq;
                const float sc = rs[ai * 4 + m], sc2 = sc * sc, scl = -1.4426950408889634f * sc;
                typedef float f2 __attribute__((ext_vector_type(2)));
                const float isc = __builtin_amdgcn_rcpf(sc2); const f2 scl2 = {scl, scl}, isc2 = {isc, isc};
                f2 e[4], gu[4]; float h[8];
#pragma unroll
                for (int n = 0; n < 2; ++n)
#pragma unroll
                    for (int jp = 0; jp < 2; ++jp) { const f2 g = {acc[ai][0][m][n][2 * jp], acc[ai][0][m][n][2 * jp + 1]}, uu = {acc[ai][1][m][n][2 * jp], acc[ai][1][m][n][2 * jp + 1]};
                        const f2 t = g * scl2; e[2 * n + jp] = (f2){__builtin_amdgcn_exp2f(t.x), __builtin_amdgcn_exp2f(t.y)}; gu[2 * n + jp] = g * uu; }
#pragma unroll
                for (int k = 0; k < 4; ++k) { const f2 d = __builtin_elementwise_fma(e[k], isc2, isc2); e[k] = (f2){__builtin_amdgcn_rcpf(d.x), __builtin_amdgcn_rcpf(d.y)}; }
#pragma unroll
                for (int k = 0; k < 4; ++k) { const f2 hh = gu[k] * e[k]; h[2 * k] = hh.x; h[2 * k + 1] = hh.y; }
                u32x4 w; w.x = cvt_pk_bf16(h[0], h[1]); w.y = cvt_pk_bf16(h[2], h[3]); w.z = cvt_pk_bf16(h[4], h[5]); w.w = cvt_pk_bf16(h[6], h[7]);
                *(u32x4*)rowp = w; }
    }
};
struct EpiResid {
    static constexpr bool PERM = true, AFTER_DRAIN = false;
    const bf16_t* res; bf16_t* out; float* SS; int ldc; int half;
    PG8_LAS unsigned char* lds;
    __device__ __forceinline__ void load_half(u32x4 (&r)[4][2], int ai, const bf16_t* rb) const {
#pragma unroll
        for (int m = 0; m < 4; ++m)
#pragma unroll
            for (int bj = 0; bj < 2; ++bj) r[m][bj] = *(const u32x4*)(rb + bj * 32768 + ai * 8192 + m * 1024);
    }
    __device__ __forceinline__ void store_half(const u32x4 (&r)[4][2], const f32x4 (&acc)[2][2][4][2], int ai, bf16_t* ob, int row0, int pn, int wc, int fq, float scale, int uui) const {
#pragma unroll
        for (int m = 0; m < 4; ++m) { const int row = row0 + ai * HALF + m * 16; float q = 0.f;
            if (half == 2) scale = ((const PG8_LAS float*)(lds + GS_LDS_OFF))[(size_t)((uui * 256 + (row & 255)) * 8 + 7)];
#pragma unroll
            for (int bj = 0; bj < 2; ++bj) { const u32x4 w0 = r[m][bj]; const f32x4 a0 = acc[ai][bj][m][0], a1 = acc[ai][bj][m][1];
                const float x0 = bf_lo(w0.x) + a0[0] * scale, x1 = bf_hi(w0.x) + a0[1] * scale, x2 = bf_lo(w0.y) + a0[2] * scale, x3 = bf_hi(w0.y) + a0[3] * scale;
                const float x4 = bf_lo(w0.z) + a1[0] * scale, x5 = bf_hi(w0.z) + a1[1] * scale, x6 = bf_lo(w0.w) + a1[2] * scale, x7 = bf_hi(w0.w) + a1[3] * scale;
                u32x4 w; w.x = cvt_pk_bf16(x0, x1); w.y = cvt_pk_bf16(x2, x3); w.z = cvt_pk_bf16(x4, x5); w.w = cvt_pk_bf16(x6, x7);
                *(u32x4*)(ob + bj * 32768 + ai * 8192 + m * 1024) = w;
                q += ((x0 * x0 + x1 * x1) + (x2 * x2 + x3 * x3)) + ((x4 * x4 + x5 * x5) + (x6 * x6 + x7 * x7)); }
            q += __shfl_xor(q, 16); q += __shfl_xor(q, 32);
            if (fq == 0) SS[(size_t)row * 32 + pn * 4 + wc] = q; }
    }
    __device__ __forceinline__ void operator()(const f32x4 (&acc)[2][2][4][2], const Unit& u, int wr, int wc, int fr, int fq) const {
        const int row0 = u.pm * BM + wr * 64 + fr; const float scale = half ? 0.5f : 1.0f;
        const size_t base = ((size_t)(u.pm * (ldc >> 6) + u.pn * 4 + (wc >> 1)) * BM + (wr * 64 + fr)) * 64 + (wc & 1) * 32 + 8 * fq;
        u32x4 ra[4][2], rb[4][2];
        load_half(ra, 0, res + base); load_half(rb, 1, res + base);
        store_half(ra, acc, 0, out + base, row0, u.pn, wc, fq, scale, u.ui);
        store_half(rb, acc, 1, out + base, row0, u.pn, wc, fq, scale, u.ui);
    }
};
struct EpiEvenIn {
    static constexpr bool PERM = true, AFTER_DRAIN = false;
    bf16_t *Q, *K, *V, *U; const float* rot; PG8_LAS unsigned char* lds;
    __device__ __forceinline__ void operator()(const f32x4 (&acc)[2][2][4][2], const Unit& u, int wr, int wc, int fr, int fq) const {
        const int pn = u.pn; bf16_t* dst; int ldc, colt; bool rotary = false; float sc = 1.f;
        if (pn < 4) { dst = Q; ldc = 1024; colt = pn * 256; rotary = true; sc = 0.125f; }
        else if (pn == 4) { dst = K; ldc = 256; colt = 0; rotary = true; }
        else if (pn == 5) { dst = V; ldc = 256; colt = 0; }
        else { dst = U; ldc = 1024; colt = (pn - 6) * 256; }
        const int row0 = u.pm * BM + wr * 64 + fr, col0 = colt + wc * 32 + 8 * fq;
        const bool rotw = rotary && ((wc & 1) == 0);
        float rs[8]; row_scales(lds, u, wr, fr, rs);
#pragma unroll
        for (int aim = 0; aim < 4; ++aim) { const int ai = aim >> 1;
            f32x4 cs[4][4];
            if (rotw) {
#pragma unroll
                for (int m = 2 * (aim & 1); m < 2 * (aim & 1) + 2; ++m) { const f32x4* rp = (const f32x4*)(rot + (size_t)(row0 + ai * HALF + m * 16) * 16); cs[m][0] = rp[0]; cs[m][1] = rp[1]; cs[m][2] = rp[2]; cs[m][3] = rp[3]; }
            }
#pragma unroll
            for (int m = 2 * (aim & 1); m < 2 * (aim & 1) + 2; ++m) { const int row = row0 + ai * HALF + m * 16; bf16_t* rowp = dst + (size_t)row * ldc + col0;
#pragma unroll
                for (int bj = 0; bj < 2; ++bj) { f32x4 v0 = acc[ai][bj][m][0] * rs[ai * 4 + m], v1 = acc[ai][bj][m][1] * rs[ai * 4 + m];
                    if (rotw) { const f32x4 p0 = shfl_xor4(v0, 16), p1 = shfl_xor4(v1, 16);
                        if (fq == 0) { v0 = v0 * cs[m][0] - p0 * cs[m][2]; v1 = v1 * cs[m][1] - p1 * cs[m][3]; }
                        else if (fq == 1) { v0 = v0 * cs[m][0] + p0 * cs[m][2]; v1 = v1 * cs[m][1] + p1 * cs[m][3]; } }
                    v0 = v0 * sc; v1 = v1 * sc;
                    u32x4 w; w.x = cvt_pk_bf16(v0[0], v0[1]); w.y = cvt_pk_bf16(v0[2], v0[3]); w.z = cvt_pk_bf16(v1[0], v1[1]); w.w = cvt_pk_bf16(v1[2], v1[3]);
                    *(u32x4*)(rowp + bj * HALF) = w; } }
        }
    }
};
struct EpiGLU {
    static constexpr bool PERM = true, AFTER_DRAIN = false;
    const bf16_t* G; const float* bias; bf16_t* CAT;
    __device__ __forceinline__ void operator()(const f32x4 (&acc)[2][2][4][2], const Unit& u, int wr, int wc, int fr, int fq) const {
        const int row0 = u.pm * BM + wr * 64 + fr, col0 = u.pn * BM + wc * 32 + 8 * fq;
        f32x4 bv[2][2];
#pragma unroll
        for (int bj = 0; bj < 2; ++bj) { bv[bj][0] = *(const f32x4*)(bias + col0 + bj * HALF); bv[bj][1] = *(const f32x4*)(bias + col0 + bj * HALF + 4); }
#pragma unroll
        for (int ai = 0; ai < 2; ++ai) {
            u32x4 gw[4][2];
#pragma unroll
            for (int m = 0; m < 4; ++m)
#pragma unroll
                for (int bj = 0; bj < 2; ++bj) gw[m][bj] = *(const u32x4*)(G + (size_t)(row0 + ai * HALF + m * 16) * 1024 + col0 + bj * HALF);
#pragma unroll
            for (int m = 0; m < 4; ++m) { const int row = row0 + ai * HALF + m * 16;
#pragma unroll
                for (int bj = 0; bj < 2; ++bj) { const int col = col0 + bj * HALF; const u32x4 g4 = gw[m][bj];
                    const f32x4 a0 = acc[ai][bj][m][0] + bv[bj][0], a1 = acc[ai][bj][m][1] + bv[bj][1];
                    float o[8];
                    o[0] = bf_lo(g4.x) * fast_sigmoid(a0[0]); o[1] = bf_hi(g4.x) * fast_sigmoid(a0[1]); o[2] = bf_lo(g4.y) * fast_sigmoid(a0[2]); o[3] = bf_hi(g4.y) * fast_sigmoid(a0[3]);
                    o[4] = bf_lo(g4.z) * fast_sigmoid(a1[0]); o[5] = bf_hi(g4.z) * fast_sigmoid(a1[1]); o[6] = bf_lo(g4.w) * fast_sigmoid(a1[2]); o[7] = bf_hi(g4.w) * fast_sigmoid(a1[3]);
                    u32x4 w; w.x = cvt_pk_bf16(o[0], o[1]); w.y = cvt_pk_bf16(o[2], o[3]); w.z = cvt_pk_bf16(o[4], o[5]); w.w = cvt_pk_bf16(o[6], o[7]);
                    *(u32x4*)(CAT + (size_t)row * 2048 + 1024 + col) = w; } }
        }
    }
};
struct EpiOddIn {
    static constexpr bool PERM = true, AFTER_DRAIN = false;
    bf16_t *Z, *XBC; float* DT; PG8_LAS unsigned char* lds;
    __device__ __forceinline__ void operator()(const f32x4 (&acc)[2][2][4][2], const Unit& u, int wr, int wc, int fr, int fq) const {
        const int pn = u.pn; const int row0 = u.pm * BM + wr * 64 + fr;
        float rs[8]; row_scales(lds, u, wr, fr, rs);
        if (pn == 40) {
            if (wc < 2) {
#pragma unroll
                for (int ai = 0; ai < 2; ++ai)
#pragma unroll
                    for (int m = 0; m < 4; ++m) { float* rowp = DT + (size_t)(row0 + ai * HALF + m * 16) * 64 + wc * 32 + 8 * fq;
                        *(f32x4*)rowp = acc[ai][0][m][0] * rs[ai * 4 + m]; *(f32x4*)(rowp + 4) = acc[ai][0][m][1] * rs[ai * 4 + m]; }
            }
            return;
        }
        bf16_t* dst; int ldc, colt;
        if (pn < 16) { dst = Z; ldc = 4096; colt = pn * 256; } else { dst = XBC; ldc = 6144; colt = (pn - 16) * 256; }
        const int col0 = colt + wc * 32 + 8 * fq;
#pragma unroll
        for (int ai = 0; ai < 2; ++ai)
#pragma unroll
            for (int m = 0; m < 4; ++m) { bf16_t* rowp = dst + (size_t)(row0 + ai * HALF + m * 16) * ldc + col0;
#pragma unroll
                for (int bj = 0; bj < 2; ++bj) { const f32x4 v0 = acc[ai][bj][m][0] * rs[ai * 4 + m], v1 = acc[ai][bj][m][1] * rs[ai * 4 + m];
                    u32x4 w; w.x = cvt_pk_bf16(v0[0], v0[1]); w.y = cvt_pk_bf16(v0[2], v0[3]); w.z = cvt_pk_bf16(v1[0], v1[1]); w.w = cvt_pk_bf16(v1[2], v1[3]);
                    *(u32x4*)(rowp + bj * HALF) = w; } }
    }
};

template <class Epi, class Sched, bool ALIGN_EPI = false, bool SP2 = false, bool TILED_A = false, bool TILED_B = false, bool GSCALE = false>
__device__ __forceinline__ void gemm_phase(PG8_LAS unsigned char* lds, const Gemm g, const Sched& S, const Epi& E, int tid_in) {
    int tid = tid_in; const int wid = __builtin_amdgcn_readfirstlane(tid >> 6), lane = tid & 63, wr = wid >> 2, wc = wid & 3, fr = lane & 15, fq = lane >> 4;
    const int K = g.K, nt = K / BK;
    unsigned voffA[2], voffB[2];
#pragma unroll
    for (int i = 0; i < 2; ++i) { int R, C; stage_rc(tid * 16 + i * 8192, R, C); const int Rb = Epi::PERM ? ((R & ~31) + perm32(R & 31)) : R;
        voffA[i] = (unsigned)(R * (TILED_A ? BK : K) + C) * 2u; voffB[i] = (unsigned)(Rb * (TILED_B ? BK : K) + C) * 2u; }
    const size_t kstepA = TILED_A ? (size_t)(BM * BK * 2) : (size_t)(BK * 2), kstepB = TILED_B ? (size_t)(BM * BK * 2) : (size_t)(BK * 2);
    const size_t hstepA = TILED_A ? (size_t)(HALF * BK * 2) : (size_t)HALF * K * 2, hstepB = TILED_B ? (size_t)(HALF * BK * 2) : (size_t)HALF * K * 2;
    const size_t tstepA = TILED_A ? (size_t)nt * (BM * BK * 2) : 2 * hstepA, tstepB = TILED_B ? (size_t)nt * (BM * BK * 2) : 2 * hstepB;
    const unsigned ldsw = (unsigned)wid * 1024u;
    const int aoff = lds_byte(wr * 64 + fr, fq * 8), boff = lds_byte(wc * 32 + fr, fq * 8);
#define PG8_SA(b, h) (((b) * 2 + (h)) * HTB)
#define PG8_SB(b, h) ((4 + (b) * 2 + (h)) * HTB)
#define PG8_STAGE(bufoff, gbase, voff) do { _Pragma("unroll") for (int _i = 0; _i < 2; ++_i) \
        __builtin_amdgcn_global_load_lds((const unsigned*)((const char*)(gbase) + (voff)[_i]), (PG8_LAS unsigned*)(lds + (bufoff) + ldsw + _i * 8192), 16, 0, 0); } while (0)
#define PG8_LDA(dst, b, h) do { _Pragma("unroll") for (int m = 0; m < 4; ++m) _Pragma("unroll") for (int k = 0; k < 2; ++k) dst[m][k] = *(const PG8_LAS bf16x8*)(lds + PG8_SA(b, h) + aoff + m * 2048 + k * 1024); } while (0)
#define PG8_LDB(dst, b, h) do { _Pragma("unroll") for (int n = 0; n < 2; ++n) _Pragma("unroll") for (int k = 0; k < 2; ++k) dst[n][k] = *(const PG8_LAS bf16x8*)(lds + PG8_SB(b, h) + boff + n * 2048 + k * 1024); } while (0)
#define PG8_MMA(ai, bj, At, Bt) do { __builtin_amdgcn_s_setprio(1); _Pragma("unroll") for (int m = 0; m < 4; ++m) _Pragma("unroll") for (int n = 0; n < 2; ++n) _Pragma("unroll") for (int k = 0; k < 2; ++k) \
        acc[ai][bj][m][n] = __builtin_amdgcn_mfma_f32_16x16x32_bf16(Bt[n][k], At[m][k], acc[ai][bj][m][n], 0, 0, 0); __builtin_amdgcn_s_setprio(0); } while (0)
#define PG8_WAIT_V(n) asm volatile("s_waitcnt vmcnt(" #n ")" ::: "memory")
#define PG8_WAIT_L(n) asm volatile("s_waitcnt lgkmcnt(" #n ")" ::: "memory")
#define PG8_BAR __builtin_amdgcn_s_barrier()
#define PG8_SCHED __builtin_amdgcn_sched_barrier(0)
    Unit cur, nxt; int ui = 0;
    if (!S.next(0, cur)) return;
    cur.ui = 0;
    f32x4 acc[2][2][4][2];
    typedef unsigned long pg8_u64x2 __attribute__((ext_vector_type(2)));
#define PG8_ZERO_ACC() do { unsigned long z64 = 0ul; asm volatile("" : "+v"(z64));     \
        _Pragma("unroll") for (int a = 0; a < 2; ++a) _Pragma("unroll") for (int b = 0; b < 2; ++b) _Pragma("unroll") for (int m = 0; m < 4; ++m) _Pragma("unroll") for (int n = 0; n < 2; ++n) \
            acc[a][b][m][n] = __builtin_bit_cast(f32x4, (pg8_u64x2){z64, z64}); } while (0)
    PG8_ZERO_ACC();
    bf16x8 At[4][2], B0[2][2], B1[2][2];
    const char* cA = (const char*)g.A + (size_t)cur.pm * tstepA; const char* cB = (const char*)g.Bt + (size_t)cur.pn * tstepB;
    S.a_ready(cur);
    if constexpr (SP2) {
        PG8_STAGE(PG8_SB(0, 0), cB, voffB); PG8_STAGE(PG8_SB(0, 1), cB + hstepB, voffB); PG8_STAGE(PG8_SA(0, 0), cA, voffA); PG8_STAGE(PG8_SA(0, 1), cA + hstepA, voffA);
        if (wr == 1) PG8_BAR;
        PG8_WAIT_V(2); PG8_BAR;
        PG8_STAGE(PG8_SB(1, 0), cB + kstepB, voffB); PG8_STAGE(PG8_SA(1, 0), cA + kstepA, voffA); PG8_STAGE(PG8_SB(1, 1), cB + hstepB + kstepB, voffB);
        PG8_WAIT_V(6); PG8_BAR;
    } else {
        PG8_STAGE(PG8_SB(0, 0), cB, voffB); PG8_STAGE(PG8_SA(0, 0), cA, voffA); PG8_STAGE(PG8_SB(0, 1), cB + hstepB, voffB); PG8_STAGE(PG8_SA(0, 1), cA + hstepA, voffA);
        if (wr == 1) PG8_BAR;
        PG8_WAIT_V(4); PG8_BAR;
        PG8_STAGE(PG8_SB(1, 0), cB + kstepB, voffB); PG8_STAGE(PG8_SA(1, 0), cA + kstepA, voffA); PG8_STAGE(PG8_SB(1, 1), cB + hstepB + kstepB, voffB);
        PG8_WAIT_V(6); PG8_BAR;
    }
    for (;;) {
        const bool has_next = S.next(ui + 1, nxt); nxt.ui = ui + 1;
        const char* nA = has_next ? (const char*)g.A + (size_t)nxt.pm * tstepA : cA; const char* nB = has_next ? (const char*)g.Bt + (size_t)nxt.pn * tstepB : cB;
        for (int t = 0; t < nt; t += 2) {
            const bool last = (t == nt - 2);
            const char* a1 = cA + (size_t)(t + 1) * kstepA;
            const char* a2 = last ? nA : cA + (size_t)(t + 2) * kstepA; const char* b2 = last ? nB : cB + (size_t)(t + 2) * kstepB;
            const char* a3 = a2 + kstepA; const char* b3 = b2 + kstepB;
            if (last && has_next) S.a_ready(nxt);
            if constexpr (GSCALE) { int tq = t; asm volatile("" : "+s"(tq));
              if (tq > 0 && (tq & 7) == 0) {
                const PG8_LAS float* gt = (const PG8_LAS float*)(lds + GS_LDS_OFF) + (size_t)((cur.ui * 256 + wr * 64 + fr) * 8 + (tq >> 3) - 1);
#pragma unroll
                for (int a = 0; a < 2; ++a)
#pragma unroll
                    for (int m = 0; m < 4; ++m) { const float rr = gt[(a * HALF + m * 16) * 8];
#pragma unroll
                        for (int bq = 0; bq < 2; ++bq)
#pragma unroll
                            for (int n = 0; n < 2; ++n) acc[a][bq][m][n] = acc[a][bq][m][n] * rr; }
                PG8_SCHED; } }
            if constexpr (SP2) {
            PG8_LDB(B0, 0, 0); PG8_LDB(B1, 0, 1); PG8_SCHED; PG8_LDA(At, 0, 0); PG8_STAGE(PG8_SA(1, 1), a1 + hstepA, voffA);
            PG8_WAIT_V(8); PG8_WAIT_L(0); PG8_BAR; PG8_MMA(0, 0, At, B0); PG8_MMA(0, 1, At, B1); PG8_BAR; PG8_SCHED;
            PG8_LDA(At, 0, 1); PG8_STAGE(PG8_SB(0, 0), b2, voffB); PG8_STAGE(PG8_SB(0, 1), b2 + hstepB, voffB); PG8_STAGE(PG8_SA(0, 0), a2, voffA);
            PG8_WAIT_V(8); PG8_WAIT_L(0); PG8_BAR; PG8_MMA(1, 0, At, B0); PG8_MMA(1, 1, At, B1); PG8_BAR; PG8_SCHED;
            PG8_LDB(B0, 1, 0); PG8_LDB(B1, 1, 1); PG8_SCHED; PG8_LDA(At, 1, 0); PG8_STAGE(PG8_SA(0, 1), a2 + hstepA, voffA);
            PG8_WAIT_V(8); PG8_WAIT_L(0); PG8_BAR; PG8_MMA(0, 0, At, B0); PG8_MMA(0, 1, At, B1); PG8_BAR; PG8_SCHED;
            PG8_LDA(At, 1, 1); PG8_STAGE(PG8_SB(1, 0), b3, voffB); PG8_STAGE(PG8_SB(1, 1), b3 + hstepB, voffB); PG8_STAGE(PG8_SA(1, 0), a3, voffA);
            PG8_WAIT_V(8); PG8_WAIT_L(0); PG8_BAR; PG8_MMA(1, 0, At, B0); PG8_MMA(1, 1, At, B1); PG8_BAR; PG8_SCHED;
            } else {
            PG8_LDB(B0, 0, 0); PG8_SCHED; PG8_LDA(At, 0, 0); PG8_STAGE(PG8_SA(1, 1), a1 + hstepA, voffA);
            PG8_WAIT_L(8); PG8_BAR; PG8_WAIT_L(0); PG8_MMA(0, 0, At, B0); PG8_BAR; PG8_SCHED;
            PG8_LDB(B1, 0, 1); PG8_STAGE(PG8_SB(0, 0), b2, voffB);
            PG8_BAR; PG8_WAIT_L(0); PG8_MMA(0, 1, At, B1); PG8_BAR;
            PG8_LDA(At, 0, 1); PG8_STAGE(PG8_SA(0, 0), a2, voffA);
            PG8_BAR; PG8_WAIT_L(0); PG8_MMA(1, 0, At, B0); PG8_BAR; PG8_SCHED;
            PG8_STAGE(PG8_SB(0, 1), b2 + hstepB, voffB);
            PG8_WAIT_V(6); PG8_BAR; PG8_MMA(1, 1, At, B1); PG8_BAR;
            PG8_LDB(B0, 1, 0); PG8_SCHED; PG8_LDA(At, 1, 0); PG8_STAGE(PG8_SA(0, 1), a2 + hstepA, voffA);
            PG8_WAIT_L(8); PG8_BAR; PG8_WAIT_L(0); PG8_MMA(0, 0, At, B0); PG8_BAR; PG8_SCHED;
            PG8_LDB(B1, 1, 1); PG8_STAGE(PG8_SB(1, 0), b3, voffB);
            PG8_BAR; PG8_WAIT_L(0); PG8_MMA(0, 1, At, B1); PG8_BAR;
            PG8_LDA(At, 1, 1); PG8_STAGE(PG8_SA(1, 0), a3, voffA);
            PG8_BAR; PG8_WAIT_L(0); PG8_MMA(1, 0, At, B0); PG8_BAR; PG8_SCHED;
            PG8_STAGE(PG8_SB(1, 1), b3 + hstepB, voffB);
            PG8_WAIT_V(6); PG8_BAR; PG8_MMA(1, 1, At, B1); PG8_BAR;
            }
        }
        if constexpr (ALIGN_EPI) { if (wr == 0) PG8_BAR; }
        if constexpr (!Epi::AFTER_DRAIN) { int fr_e = fr, fq_e = fq; asm volatile("" : "+v"(fr_e), "+v"(fq_e));
            E(acc, cur, wr, wc, fr_e, fq_e); S.done(cur); }
        if (!has_next) break;
        PG8_ZERO_ACC();
        cur = nxt; cA = nA; cB = nB; ++ui;
        if constexpr (ALIGN_EPI) { if (wr == 1) PG8_BAR; }
    }
    PG8_WAIT_V(0);
    if constexpr (!ALIGN_EPI) { if (wr == 0) PG8_BAR; }
    PG8_BAR;
    if constexpr (Epi::AFTER_DRAIN) { E.fused(acc, cur, wr, wc, fr, fq, lds, wid, lane); S.done(cur); }
#undef PG8_SA
#undef PG8_SB
#undef PG8_STAGE
#undef PG8_LDA
#undef PG8_LDB
#undef PG8_MMA
#undef PG8_ZERO_ACC
#undef PG8_WAIT_V
#undef PG8_WAIT_L
#undef PG8_BAR
#undef PG8_SCHED
}
}

#define GAS __attribute__((address_space(1)))
#define LAS __attribute__((address_space(3)))
#define CAS __attribute__((address_space(4)))
typedef unsigned short bf16;
typedef unsigned v4u __attribute__((ext_vector_type(4)));
typedef unsigned v2u __attribute__((ext_vector_type(2)));
typedef float f32x4 __attribute__((ext_vector_type(4)));
typedef float f32x2v __attribute__((ext_vector_type(2)));
typedef __bf16 bf16x2v __attribute__((ext_vector_type(2)));
__device__ __forceinline__ unsigned pkbf(float a, float b) { const f32x2v v = {a, b}; const bf16x2v r = __builtin_convertvector(v, bf16x2v); return __builtin_bit_cast(unsigned, r); }
#define LDS_WAIT() asm volatile("s_waitcnt lgkmcnt(0)" ::: "memory")
#define LDS_BARRIER() do { asm volatile("s_waitcnt lgkmcnt(0)" ::: "memory"); __builtin_amdgcn_s_barrier(); asm volatile("" ::: "memory"); } while (0)
__device__ __forceinline__ unsigned f2bf(float f) { unsigned u = __builtin_bit_cast(unsigned, f); return (u + 0x7fffu + ((u >> 16) & 1u)) >> 16; }
__device__ __forceinline__ unsigned pk2(float lo, float hi) { return f2bf(lo) | (f2bf(hi) << 16); }
__device__ __forceinline__ float bf2f(unsigned short b) { return __uint_as_float(((unsigned)b) << 16); }
__device__ __forceinline__ float blo(unsigned w) { return __uint_as_float(w << 16); }
__device__ __forceinline__ float bhi(unsigned w) { return __uint_as_float(w & 0xffff0000u); }
__device__ __forceinline__ float wave_sum(float v) {
#pragma unroll
    for (int o = 1; o < 64; o <<= 1) v += __shfl_xor(v, o);
    return v;
}
__device__ __forceinline__ float wave_max(float v) {
#pragma unroll
    for (int o = 1; o < 64; o <<= 1) v = fmaxf(v, __shfl_xor(v, o));
    return v;
}
__device__ __forceinline__ float sigmoidf_(float x) { return __builtin_amdgcn_rcpf(1.0f + __expf(-x)); }
__device__ __forceinline__ float fsig(float x) { return __builtin_amdgcn_rcpf(1.0f + __expf(-x)); }
__device__ __forceinline__ float siluf_(float x) { return x * sigmoidf_(x); }
__device__ __forceinline__ float gelu_tanh(float x) { const float z = 0.7978845608028654f * (x + 0.044715f * x * x * x); const float t = 1.0f - 2.0f * __builtin_amdgcn_rcpf(__expf(2.0f * z) + 1.0f); return 0.5f * x * (1.0f + t); }
__device__ __forceinline__ float softplusf_(float x) { const float e = __expf(x); return x > 20.f ? x : (e < 1e-3f ? e * (1.0f - 0.5f * e) : __logf(1.0f + e)); }

#define XB_TMO      128
#define XB_XCNT(j)  (256  + 64 * (j))
#define XB_XSUB(j)  (1280 + 64 * (j))
#define XB_XGEN(j)  (2304 + 64 * (j))
#define XB_TOP      3328
#define XB_TOPGEN   3392
#define XCD_BAR_WORDS 3456
#define XB_SPIN_CAP (1u << 18)

__device__ __forceinline__ unsigned xb_ld(unsigned* p)              { return __hip_atomic_load(p, __ATOMIC_RELAXED, __HIP_MEMORY_SCOPE_AGENT); }
__device__ __forceinline__ unsigned xb_add(unsigned* p, unsigned v) { return __hip_atomic_fetch_add(p, v, __ATOMIC_RELAXED, __HIP_MEMORY_SCOPE_AGENT); }
__device__ __forceinline__ unsigned xb_xcc_id() { return (unsigned)__builtin_amdgcn_s_getreg((3 << 11) | 20) & 0xFu; }
#define XB_SPIN(cond, bar) do { unsigned _sp = 0; while (cond) { __builtin_amdgcn_s_sleep(1); \
    if ((++_sp & 255u) == 0u) { if (xb_ld(&(bar)[XB_TMO])) break; if (_sp > XB_SPIN_CAP) { atomicAdd(&(bar)[XB_TMO], 1u); break; } } } } while (0)

struct XcdBarrier {
    unsigned* bar; unsigned x;
    volatile LAS unsigned* st; bool lead;
};

__device__ __forceinline__ XcdBarrier xcd_barrier_post(unsigned* bar, volatile LAS unsigned* st) {
    XcdBarrier b; b.bar = bar; b.x = xb_xcc_id(); b.st = st;
    if (threadIdx.x == 0) (void)xb_add(&bar[XB_XCNT(b.x)], 1u);
    return b;
}
__device__ __forceinline__ void xcd_barrier_complete(unsigned* bar, unsigned x, unsigned& nloc, unsigned& nx) {
    const unsigned G = gridDim.x * gridDim.y * gridDim.z;
    unsigned sum, cnt, mine, sp = 0u;
    for (;;) {
        sum = 0u; cnt = 0u; mine = 0u;
#pragma unroll
        for (unsigned j = 0; j < 16; ++j) { const unsigned c = xb_ld(&bar[XB_XCNT(j)]); sum += c; cnt += (c > 0u) ? 1u : 0u; mine = (j == x) ? c : mine; }
        if (sum == G) break;
        __builtin_amdgcn_s_sleep(1);
        if ((++sp & 255u) == 0u) { if (xb_ld(&bar[XB_TMO])) break; if (sp > XB_SPIN_CAP) { atomicAdd(&bar[XB_TMO], 1u); break; } }
    }
    nloc = mine > 0u ? mine : 1u; nx = cnt > 0u ? cnt : 1u;
}

__device__ __forceinline__ void xcd_barrier(const XcdBarrier& b) {
    asm volatile("s_waitcnt vmcnt(0)" ::: "memory");
    __syncthreads();
    if (b.lead) {
        unsigned* bar = b.bar;
        __builtin_amdgcn_s_waitcnt(0);
        unsigned nloc = b.st[0], nx = b.st[1];
        if (nloc == 0u) { xcd_barrier_complete(bar, b.x, nloc, nx); b.st[0] = nloc; b.st[1] = nx; }
        const unsigned old = xb_add(&bar[XB_XSUB(b.x)], 1u);
        const unsigned gen = old / nloc;
        if (old + 1u == (gen + 1u) * nloc) {
            __builtin_amdgcn_fence(__ATOMIC_RELEASE, "agent");
            asm volatile("s_waitcnt vmcnt(0)" ::: "memory");
            const unsigned og = xb_add(&bar[XB_TOP], 1u);
            const unsigned tg = og / nx;
            if (og + 1u == (tg + 1u) * nx) xb_add(&bar[XB_TOPGEN], 1u);
            else XB_SPIN(xb_ld(&bar[XB_TOPGEN]) == tg, bar);
            __builtin_amdgcn_fence(__ATOMIC_ACQUIRE, "agent");
            xb_add(&bar[XB_XGEN(b.x)], 1u);
            asm volatile("s_waitcnt vmcnt(0)" ::: "memory");
        } else {
            XB_SPIN(xb_ld(&bar[XB_XGEN(b.x)]) == gen, bar);
            __builtin_amdgcn_fence(__ATOMIC_ACQUIRE, "agent");
            asm volatile("s_waitcnt vmcnt(0)" ::: "memory");
        }
    }
    __syncthreads();
}

constexpr size_t MiB = 1u << 20;
constexpr size_t WS_CTL = 0, CTL_ZERO_BYTES = 64 * 1024;
constexpr size_t WS_ROT = 1 * MiB;
constexpr size_t WS_X = 2 * MiB;
constexpr size_t WS_XN = 130 * MiB;
constexpr size_t WS_R = 194 * MiB;
constexpr size_t R_H = 0;
constexpr size_t R_Q = 0, R_K = 32 * MiB, R_V = 40 * MiB, R_U = 48 * MiB, R_G = 80 * MiB, R_CAT = 112 * MiB;
constexpr size_t R_Z = 0, R_XBC = 128 * MiB, R_XBCC = 320 * MiB, R_DT = 512 * MiB, R_YG = 128 * MiB, R_YN = 0;
constexpr size_t WS_W = 710 * MiB;
constexpr size_t W_GU0 = 0, W_D0 = 44 * MiB, W_GU1 = 66 * MiB, W_D1 = 110 * MiB, W_MIX = 132 * MiB;
constexpr size_t W_EIN = W_MIX, W_EGLU = W_MIX + 10 * MiB, W_EOUT = W_MIX + 12 * MiB;
constexpr size_t W_OIN = W_MIX, W_OOUT = W_MIX + 41 * MiB;
constexpr size_t WS_SS = 899 * MiB;
constexpr size_t WS_SSG = 901 * MiB;
constexpr size_t WS_END = 905 * MiB;
constexpr int CW_BAR = 1024;
static_assert((CW_BAR + XCD_BAR_WORDS) * 4 <= (int)CTL_ZERO_BYTES, "barrier words inside the memset region");

constexpr int RING_BYTES = 131072;
constexpr int MISC_OFF = 163840 - 64;
constexpr int LDS_BYTES = 163840;

struct Params { const void* in[33]; float* out; unsigned char* ws; int lo, hi; };

enum { I_X = 0, I_POS, I_NFFN1, I_F1G, I_F1U, I_F1D, I_NMIX, I_NFFN2, I_F2G, I_F2U, I_F2D, I_EWIN, I_SINK, I_ARE, I_AIM, I_LOGDT, I_BRE, I_BIM, I_CRE, I_CIM, I_S5D, I_WGLU, I_BGLU, I_EWOUT,
       I_MWIN, I_CONVW, I_CONVB, I_DTB, I_ALOG, I_MD, I_MNORM, I_MWOUT, I_FNORM };

__device__ __forceinline__ void convert_matrix(const float* W, int K, int N, bf16* WT, int grp, int gstride, int off, LAS float* scr, int gw, int NGW, int lane) {
    const int nblk = N / 32, nitems = (K / 64) * nblk;
    for (int item = gw; item < nitems; item += NGW) {
        const int kb = item / nblk, nb = item % nblk, k0 = 64 * kb, n0 = 32 * nb;
#pragma unroll 8
        for (int i = 0; i < 32; ++i) { const int kk = 2 * i + (lane >> 5); scr[kk * 33 + (lane & 31)] = W[(size_t)(k0 + kk) * N + n0 + (lane & 31)]; }
        LDS_WAIT(); asm volatile("" ::: "memory");
        const int c = lane & 7;
#pragma unroll
        for (int j = 0; j < 4; ++j) { const int n = (lane >> 3) + 8 * j; const LAS float* s = scr + (8 * c) * 33 + n;
            v4u o; o.x = pk2(s[0 * 33], s[1 * 33]); o.y = pk2(s[2 * 33], s[3 * 33]); o.z = pk2(s[4 * 33], s[5 * 33]); o.w = pk2(s[6 * 33], s[7 * 33]);
            const int nn = n0 + n; const int row = (nn / grp) * gstride + (nn % grp) + off;
            *(v4u*)(WT + (size_t)row * K + k0 + 8 * c) = o; }
        LDS_WAIT(); asm volatile("" ::: "memory");
    }
}
__device__ __forceinline__ void ph_rmsnorm_bf16(const float* src, const float* g, bf16* dst, int gw, int NGW, int lane) {
    for (int m = gw; m < M_TOK; m += NGW) {
        const f32x4* xr = (const f32x4*)(src + (size_t)m * D_MODEL) + lane;
        f32x4 v[8]; float s = 0.f;
#pragma unroll
        for (int j = 0; j < 8; ++j) { v[j] = xr[64 * j]; s += (v[j].x * v[j].x + v[j].y * v[j].y) + (v[j].z * v[j].z + v[j].w * v[j].w); }
        const float r = 1.0f / sqrtf(wave_sum(s) * (1.0f / D_MODEL) + NORM_EPS);
        v2u* o8 = (v2u*)(dst + (size_t)m * D_MODEL) + lane;
#pragma unroll
        for (int j = 0; j < 8; ++j) { const f32x4 gg = ((const f32x4*)g)[lane + 64 * j]; v2u w; w.x = pk2(v[j].x * r * gg.x, v[j].y * r * gg.y); w.y = pk2(v[j].z * r * gg.z, v[j].w * r * gg.w); o8[64 * j] = w; }
    }
}
__device__ __forceinline__ size_t xb_off(int row, int col) { return ((size_t)((row >> 8) * (D_MODEL / 64) + (col >> 6)) * 256 + (row & 255)) * 64 + (col & 63); }
__device__ __forceinline__ void ph_xb_ss(const float* src, bf16* dst, float* SS, int gw, int NGW, int lane) {
    for (int m = gw; m < M_TOK; m += NGW) {
        const f32x4* xr = (const f32x4*)(src + (size_t)m * D_MODEL) + lane;
        f32x4 v[8]; float s = 0.f;
#pragma unroll
        for (int j = 0; j < 8; ++j) { v[j] = xr[64 * j]; s += (v[j].x * v[j].x + v[j].y * v[j].y) + (v[j].z * v[j].z + v[j].w * v[j].w); }
        s = wave_sum(s);
#pragma unroll
        for (int j = 0; j < 8; ++j) { v2u w; w.x = pk2(v[j].x, v[j].y); w.y = pk2(v[j].z, v[j].w); *(v2u*)(dst + xb_off(m, 4 * (lane + 64 * j))) = w; }
        if (lane < 32) SS[(size_t)m * 32 + lane] = (lane == 0) ? s : 0.f;
    }
}
__device__ __forceinline__ void ph_rmsnorm_out(const bf16* src, const float* g, float* dst, int gw, int NGW, int lane) {
    for (int m = gw; m < M_TOK; m += NGW) {
        float v[4][8]; float s = 0.f;
#pragma unroll
        for (int j = 0; j < 4; ++j) { const v4u w = *(const v4u*)(src + xb_off(m, 8 * (lane + 64 * j))); v[j][0] = blo(w.x); v[j][1] = bhi(w.x); v[j][2] = blo(w.y); v[j][3] = bhi(w.y); v[j][4] = blo(w.z); v[j][5] = bhi(w.z); v[j][6] = blo(w.w); v[j][7] = bhi(w.w);
#pragma unroll
            for (int k = 0; k < 8; ++k) s += v[j][k] * v[j][k]; }
        const float r = 1.0f / sqrtf(wave_sum(s) * (1.0f / D_MODEL) + NORM_EPS);
#pragma unroll
        for (int j = 0; j < 4; ++j) { const int c0 = 8 * (lane + 64 * j); const f32x4 g0 = *(const f32x4*)(g + c0), g1 = *(const f32x4*)(g + c0 + 4);
            f32x4 o0, o1; o0.x = v[j][0] * r * g0.x; o0.y = v[j][1] * r * g0.y; o0.z = v[j][2] * r * g0.z; o0.w = v[j][3] * r * g0.w; o1.x = v[j][4] * r * g1.x; o1.y = v[j][5] * r * g1.y; o1.z = v[j][6] * r * g1.z; o1.w = v[j][7] * r * g1.w;
            *(f32x4*)(dst + (size_t)m * D_MODEL + c0) = o0; *(f32x4*)(dst + (size_t)m * D_MODEL + c0 + 4) = o1; }
    }
}
__device__ __forceinline__ void ph_rmsnorm_f32(const float* src, const float* g, float* dst, int gw, int NGW, int lane) {
    for (int m = gw; m < M_TOK; m += NGW) {
        const f32x4* xr = (const f32x4*)(src + (size_t)m * D_MODEL) + lane;
        f32x4 v[8]; float s = 0.f;
#pragma unroll
        for (int j = 0; j < 8; ++j) { v[j] = xr[64 * j]; s += (v[j].x * v[j].x + v[j].y * v[j].y) + (v[j].z * v[j].z + v[j].w * v[j].w); }
        const float r = 1.0f / sqrtf(wave_sum(s) * (1.0f / D_MODEL) + NORM_EPS);
        f32x4* o = (f32x4*)(dst + (size_t)m * D_MODEL) + lane;
#pragma unroll
        for (int j = 0; j < 8; ++j) { const f32x4 gg = ((const f32x4*)g)[lane + 64 * j]; o[64 * j] = v[j] * r * gg; }
    }
}
__device__ __forceinline__ void ph_attn_naive(const bf16* Q, const bf16* K, const bf16* V, const float* sinks, bf16* CAT, int gw, int NGW, int lane) {
    for (int it = gw; it < M_TOK * A_HEADS; it += NGW) {
        const int m = it >> 4, h = it & 15, kvh = h >> 2, b = m >> 12, s = m & (SEQ - 1);
        int k0 = s - (WINDOW - 1); if (k0 < 0) k0 = 0; const int nk = s - k0 + 1;
        float q[64];
        { const v4u* qp = (const v4u*)(Q + (size_t)m * A_WIDTH + h * HD);
#pragma unroll
          for (int c = 0; c < 8; ++c) { const v4u w = qp[c]; q[8 * c + 0] = blo(w.x); q[8 * c + 1] = bhi(w.x); q[8 * c + 2] = blo(w.y); q[8 * c + 3] = bhi(w.y); q[8 * c + 4] = blo(w.z); q[8 * c + 5] = bhi(w.z); q[8 * c + 6] = blo(w.w); q[8 * c + 7] = bhi(w.w); } }
        float sc[2];
#pragma unroll
        for (int r = 0; r < 2; ++r) { const int j = lane + 64 * r; float d = -1e30f;
            if (j < nk) { const v4u* kp = (const v4u*)(K + (size_t)(b * SEQ + k0 + j) * KV_WIDTH + kvh * HD); d = 0.f;
#pragma unroll
                for (int c = 0; c < 8; ++c) { const v4u w = kp[c]; d += q[8 * c + 0] * blo(w.x) + q[8 * c + 1] * bhi(w.x) + q[8 * c + 2] * blo(w.y) + q[8 * c + 3] * bhi(w.y) + q[8 * c + 4] * blo(w.z) + q[8 * c + 5] * bhi(w.z) + q[8 * c + 6] * blo(w.w) + q[8 * c + 7] * bhi(w.w); } }
            sc[r] = d; }
        const float sk = sinks[h];
        const float mx = fmaxf(wave_max(fmaxf(sc[0], sc[1])), sk);
        const float e0 = (lane < nk) ? __expf(sc[0] - mx) : 0.f, e1 = (lane + 64 < nk) ? __expf(sc[1] - mx) : 0.f;
        const float den = wave_sum(e0 + e1) + __expf(sk - mx);
        const float inv = 1.0f / den, p0 = e0 * inv, p1 = e1 * inv;
        float o = 0.f; const bf16* vp = V + (size_t)(b * SEQ + k0) * KV_WIDTH + kvh * HD + lane;
        for (int j = 0; j < nk; ++j) { const float pj = (j < 64) ? __shfl(p0, j) : __shfl(p1, j - 64); o += pj * bf2f(vp[(size_t)j * KV_WIDTH]); }
        CAT[(size_t)m * 2048 + h * HD + lane] = (bf16)f2bf(o);
    }
}
__device__ __forceinline__ void ph_s5_naive(const CAS Params* PP, int e, const bf16* U, bf16* G, LAS unsigned char* lds, int bid, int nblk, int tid_in) {
    LAS float* hbuf = (LAS float*)lds;
    LAS float* ubuf = hbuf + 64 * 132;
    LAS float* cbuf = ubuf + 64 * 16;
    int tid = tid_in; const int lane = tid & 63, wave = __builtin_amdgcn_readfirstlane(tid >> 6);
    const float* a_re = ((const float*)(const GAS float*)PP->in[I_ARE]) + (size_t)e * 64 * 64; const float* a_im = ((const float*)(const GAS float*)PP->in[I_AIM]) + (size_t)e * 64 * 64;
    const float* log_dt = ((const float*)(const GAS float*)PP->in[I_LOGDT]) + (size_t)e * 64;
    const float* b_re = ((const float*)(const GAS float*)PP->in[I_BRE]) + (size_t)e * 64 * 64 * 16; const float* b_im = ((const float*)(const GAS float*)PP->in[I_BIM]) + (size_t)e * 64 * 64 * 16;
    const float* c_re = ((const float*)(const GAS float*)PP->in[I_CRE]) + (size_t)e * 64 * 16 * 64; const float* c_im = ((const float*)(const GAS float*)PP->in[I_CIM]) + (size_t)e * 64 * 16 * 64;
    const float* d_skip = ((const float*)(const GAS float*)PP->in[I_S5D]) + (size_t)e * 1024;
    for (int unit = bid; unit < BATCH * S5_GROUPS; unit += nblk) {
        const int b = unit >> 6, g = unit & 63;
        __syncthreads();
        for (int i = tid; i < 2048; i += 512) { const int c = i >> 7, k = i & 127; cbuf[c * 132 + k] = (k < 64) ? c_re[(size_t)(g * 16 + c) * 64 + k] : -c_im[(size_t)(g * 16 + c) * 64 + (k - 64)]; }
        float abr = 0.f, abi = 0.f, bbr[16], bbi[16], hr = 0.f, hi = 0.f;
#pragma unroll
        for (int c = 0; c < 16; ++c) { bbr[c] = 0.f; bbi[c] = 0.f; }
        if (wave == 0) {
            const int p = lane; const float dt = expf(log_dt[g]); const float ar = a_re[g * 64 + p], ai = a_im[g * 64 + p];
            const float mag = expf(ar * dt); abr = mag * cosf(ai * dt); abi = mag * sinf(ai * dt);
            const float nr = abr - 1.0f, ni = abi, den = ar * ar + ai * ai; const float cr = (nr * ar + ni * ai) / den, ci = (ni * ar - nr * ai) / den;
#pragma unroll
            for (int c = 0; c < 16; ++c) { const float br = b_re[(size_t)(g * 64 + p) * 16 + c], bi = b_im[(size_t)(g * 64 + p) * 16 + c]; bbr[c] = cr * br - ci * bi; bbi[c] = cr * bi + ci * br; }
        }
        for (int chunk = 0; chunk < SEQ / 64; ++chunk) {
            const int m0 = b * SEQ + chunk * 64;
            for (int i = tid; i < 1024; i += 512) { const int t = i >> 4, c = i & 15; ubuf[i] = bf2f(U[(size_t)(m0 + t) * S5_WIDTH + g * 16 + c]); }
            __syncthreads();
            if (wave == 0) {
                for (int t = 0; t < 64; ++t) {
                    const LAS f32x4* up = (const LAS f32x4*)(ubuf + t * 16); float bur = 0.f, bui = 0.f;
#pragma unroll
                    for (int c4 = 0; c4 < 4; ++c4) { const f32x4 u4 = up[c4];
#pragma unroll
                        for (int j = 0; j < 4; ++j) { bur += bbr[4 * c4 + j] * u4[j]; bui += bbi[4 * c4 + j] * u4[j]; } }
                    const float nhr = abr * hr - abi * hi + bur, nhi = abr * hi + abi * hr + bui; hr = nhr; hi = nhi;
                    hbuf[t * 132 + lane] = hr; hbuf[t * 132 + 64 + lane] = hi;
                }
            }
            __syncthreads();
            { const int t = tid >> 3, c0 = 2 * (tid & 7); float y0 = 0.f, y1 = 0.f;
              const LAS f32x4* hp = (const LAS f32x4*)(hbuf + t * 132); const LAS f32x4* ca = (const LAS f32x4*)(cbuf + c0 * 132); const LAS f32x4* cb = (const LAS f32x4*)(cbuf + (c0 + 1) * 132);
#pragma unroll 8
              for (int k4 = 0; k4 < 32; ++k4) { const f32x4 h4 = hp[k4], a4 = ca[k4], b4 = cb[k4]; y0 += (h4.x * a4.x + h4.y * a4.y) + (h4.z * a4.z + h4.w * a4.w); y1 += (h4.x * b4.x + h4.y * b4.y) + (h4.z * b4.z + h4.w * b4.w); }
              y0 += d_skip[g * 16 + c0] * ubuf[t * 16 + c0]; y1 += d_skip[g * 16 + c0 + 1] * ubuf[t * 16 + c0 + 1];
              *(unsigned*)(G + (size_t)(m0 + t) * S5_WIDTH + g * 16 + c0) = pk2(gelu_tanh(y0), gelu_tanh(y1)); }
            __syncthreads();
        }
    }
}
__device__ __forceinline__ void ph_conv(int do_dt, const bf16* XBC, const float* cw, const float* cb, const float* dt_bias, bf16* XBCC, float* DT, int gw, int NGW, int lane, int gtid, int gthreads) {
    constexpr int RUN = 32, NCB = M_CONV_DIM / 512, NRUN = M_TOK / RUN;
    for (int it = gw; it < NCB * NRUN; it += NGW) {
        const int cbk = it % NCB, run = it / NCB, c8 = cbk * 512 + lane * 8, m0 = run * RUN, s0 = m0 & (SEQ - 1);
        float w[4][8], bias[8];
#pragma unroll
        for (int tap = 0; tap < 4; ++tap) { const f32x4 a = *(const f32x4*)(cw + (size_t)tap * M_CONV_DIM + c8), b = *(const f32x4*)(cw + (size_t)tap * M_CONV_DIM + c8 + 4);
            w[tap][0] = a.x; w[tap][1] = a.y; w[tap][2] = a.z; w[tap][3] = a.w; w[tap][4] = b.x; w[tap][5] = b.y; w[tap][6] = b.z; w[tap][7] = b.w; }
        { const f32x4 a = *(const f32x4*)(cb + c8), b = *(const f32x4*)(cb + c8 + 4); bias[0] = a.x; bias[1] = a.y; bias[2] = a.z; bias[3] = a.w; bias[4] = b.x; bias[5] = b.y; bias[6] = b.z; bias[7] = b.w; }
        v4u h0, h1, h2;
        { unsigned z0 = 0u; asm volatile("" : "+v"(z0)); const v4u z = (v4u){z0, z0, z0, z0};
          const bf16* p = XBC + (size_t)m0 * M_CONV_DIM + c8;
          h0 = (s0 >= 3) ? *(const v4u*)(p - 3 * (size_t)M_CONV_DIM) : z; h1 = (s0 >= 2) ? *(const v4u*)(p - 2 * (size_t)M_CONV_DIM) : z; h2 = (s0 >= 1) ? *(const v4u*)(p - (size_t)M_CONV_DIM) : z; }
        v4u ina[8], inb[8];
#define CONV_LOAD(dst, T0) _Pragma("unroll") for (int t = 0; t < 8; ++t) dst[t] = *(const v4u*)(XBC + (size_t)(m0 + (T0) + t) * M_CONV_DIM + c8)
#define CONV_TAP(tap, v) acc[0] += w[tap][0] * blo(v.x); acc[1] += w[tap][1] * bhi(v.x); acc[2] += w[tap][2] * blo(v.y); acc[3] += w[tap][3] * bhi(v.y); \
                         acc[4] += w[tap][4] * blo(v.z); acc[5] += w[tap][5] * bhi(v.z); acc[6] += w[tap][6] * blo(v.w); acc[7] += w[tap][7] * bhi(v.w);
#define CONV_BATCH(src, T0) _Pragma("unroll") for (int t = 0; t < 8; ++t) { const v4u cur = src[t]; float acc[8]; \
                _Pragma("unroll") for (int j = 0; j < 8; ++j) acc[j] = bias[j]; \
                CONV_TAP(0, h0) CONV_TAP(1, h1) CONV_TAP(2, h2) CONV_TAP(3, cur) \
                v4u o; o.x = pkbf(acc[0] * fsig(acc[0]), acc[1] * fsig(acc[1])); o.y = pkbf(acc[2] * fsig(acc[2]), acc[3] * fsig(acc[3])); \
                o.z = pkbf(acc[4] * fsig(acc[4]), acc[5] * fsig(acc[5])); o.w = pkbf(acc[6] * fsig(acc[6]), acc[7] * fsig(acc[7])); \
                *(v4u*)(XBCC + (size_t)(m0 + (T0) + t) * M_CONV_DIM + c8) = o; \
                h0 = h1; h1 = h2; h2 = cur; }
        CONV_LOAD(ina, 0);
#pragma unroll 1
        for (int t0 = 0; t0 < RUN; t0 += 16) {
            CONV_LOAD(inb, t0 + 8); __builtin_amdgcn_sched_barrier(0);
            CONV_BATCH(ina, t0)
            if (t0 + 16 < RUN) { CONV_LOAD(ina, t0 + 16); } __builtin_amdgcn_sched_barrier(0);
            CONV_BATCH(inb, t0 + 8)
        }
#undef CONV_LOAD
#undef CONV_TAP
#undef CONV_BATCH
    }
    if (do_dt) for (int i = gtid; i < M_TOK * M_HEADS; i += gthreads) DT[i] = softplusf_(DT[i] + dt_bias[i & 63]);
}
__device__ __forceinline__ void ph_ssd_naive(const bf16* XBCC, const float* DT, const bf16* Z, const float* a_log, const float* d_skip, bf16* YG, LAS unsigned char* lds, int bid, int nblk, int tid_in) {
    LAS float* xs = (LAS float*)lds;
    LAS float* Bs = xs + 32 * 64;
    LAS float* Cs = Bs + 32 * 128;
    LAS float* ys = Cs + 32 * 128;
    LAS float* dts = ys + 32 * 64;
    LAS float* das = dts + 32;
    int tid = tid_in; const int p = tid >> 3, nb = tid & 7;
    for (int unit = bid; unit < BATCH * M_HEADS; unit += nblk) {
        const int b = unit >> 6, h = unit & 63, grp = h >> 3; const float a = -expf(a_log[h]), Dh = d_skip[h];
        float S[16];
#pragma unroll
        for (int i = 0; i < 16; ++i) S[i] = 0.f;
        for (int chunk = 0; chunk < SEQ / 32; ++chunk) {
            const int m0 = b * SEQ + chunk * 32;
            { const int t = (tid * 4) >> 6, pp = (tid * 4) & 63; const v2u w = *(const v2u*)(XBCC + (size_t)(m0 + t) * M_CONV_DIM + h * 64 + pp);
              *(LAS f32x4*)(xs + t * 64 + pp) = (f32x4){blo(w.x), bhi(w.x), blo(w.y), bhi(w.y)}; }
            { const int t = (tid * 8) >> 7, n = (tid * 8) & 127;
              const v4u wb = *(const v4u*)(XBCC + (size_t)(m0 + t) * M_CONV_DIM + 4096 + grp * 128 + n), wc = *(const v4u*)(XBCC + (size_t)(m0 + t) * M_CONV_DIM + 5120 + grp * 128 + n);
              *(LAS f32x4*)(Bs + t * 128 + n) = (f32x4){blo(wb.x), bhi(wb.x), blo(wb.y), bhi(wb.y)}; *(LAS f32x4*)(Bs + t * 128 + n + 4) = (f32x4){blo(wb.z), bhi(wb.z), blo(wb.w), bhi(wb.w)};
              *(LAS f32x4*)(Cs + t * 128 + n) = (f32x4){blo(wc.x), bhi(wc.x), blo(wc.y), bhi(wc.y)}; *(LAS f32x4*)(Cs + t * 128 + n + 4) = (f32x4){blo(wc.z), bhi(wc.z), blo(wc.w), bhi(wc.w)}; }
            if (tid < 32) { const float dt = DT[(size_t)(m0 + tid) * 64 + h]; dts[tid] = dt; das[tid] = __expf(a * dt); }
            __syncthreads();
            for (int t = 0; t < 32; ++t) {
                const float dA = das[t], xv = xs[t * 64 + p], xdt = xv * dts[t]; float acc = 0.f;
#pragma unroll
                for (int i4 = 0; i4 < 4; ++i4) { const f32x4 B4 = *(const LAS f32x4*)(Bs + t * 128 + nb * 16 + 4 * i4), C4 = *(const LAS f32x4*)(Cs + t * 128 + nb * 16 + 4 * i4);
#pragma unroll
                    for (int j = 0; j < 4; ++j) { S[4 * i4 + j] = S[4 * i4 + j] * dA + xdt * B4[j]; acc += C4[j] * S[4 * i4 + j]; } }
                acc += __shfl_xor(acc, 1); acc += __shfl_xor(acc, 2); acc += __shfl_xor(acc, 4);
                if (nb == 0) ys[t * 64 + p] = acc + Dh * xv;
            }
            __syncthreads();
            { const int t = (tid * 4) >> 6, pp = (tid * 4) & 63; const f32x4 y4 = *(const LAS f32x4*)(ys + t * 64 + pp);
              const v2u zw = *(const v2u*)(Z + (size_t)(m0 + t) * M_INNER + h * 64 + pp);
              v2u o; o.x = pk2(y4.x * siluf_(blo(zw.x)), y4.y * siluf_(bhi(zw.x))); o.y = pk2(y4.z * siluf_(blo(zw.y)), y4.w * siluf_(bhi(zw.y)));
              *(v2u*)(YG + (size_t)(m0 + t) * M_INNER + h * 64 + pp) = o; }
        }
        __syncthreads();
    }
}
__device__ __forceinline__ void ph_gnorm(const bf16* YG, const float* ng, bf16* YN, int gw, int NGW, int lane) {
    for (int m = gw; m < M_TOK; m += NGW) {
#pragma unroll 2
        for (int g8 = 0; g8 < 8; ++g8) {
            const v4u w = *(const v4u*)(YG + (size_t)m * M_INNER + g8 * 512 + lane * 8);
            float v[8] = {blo(w.x), bhi(w.x), blo(w.y), bhi(w.y), blo(w.z), bhi(w.z), blo(w.w), bhi(w.w)};
            float s = 0.f;
#pragma unroll
            for (int j = 0; j < 8; ++j) s += v[j] * v[j];
            const float r = 1.0f / sqrtf(wave_sum(s) * (1.0f / 512.0f) + NORM_EPS);
            const f32x4 g0 = *(const f32x4*)(ng + g8 * 512 + lane * 8), g1 = *(const f32x4*)(ng + g8 * 512 + lane * 8 + 4);
            v4u o; o.x = pk2(v[0] * r * g0.x, v[1] * r * g0.y); o.y = pk2(v[2] * r * g0.z, v[3] * r * g0.w); o.z = pk2(v[4] * r * g1.x, v[5] * r * g1.y); o.w = pk2(v[6] * r * g1.z, v[7] * r * g1.w);
            *(v4u*)(YN + (size_t)m * M_INNER + g8 * 512 + lane * 8) = o;
        }
    }
}


typedef short bf16x8v __attribute__((ext_vector_type(8)));
typedef short s16x4v __attribute__((ext_vector_type(4)));
typedef float f32x16 __attribute__((ext_vector_type(16)));
#define MFMA32(a, b, c) __builtin_amdgcn_mfma_f32_32x32x16_bf16((a), (b), (c), 0, 0, 0)
__device__ __forceinline__ int crow(int reg, int h) { return (reg & 3) + 8 * (reg >> 2) + 4 * h; }
__device__ __forceinline__ bf16x8v pack8(const f32x16& x, int s) {
    v4u p; p.x = pkbf(x[8 * s + 0], x[8 * s + 1]); p.y = pkbf(x[8 * s + 2], x[8 * s + 3]); p.z = pkbf(x[8 * s + 4], x[8 * s + 5]); p.w = pkbf(x[8 * s + 6], x[8 * s + 7]);
    return __builtin_bit_cast(bf16x8v, p);
}
__device__ __forceinline__ bf16x8v tr_frag(const LAS bf16* base, int stride, int rowA, int rowB, int ctile, int lane) {
    const int i16 = lane & 15, q = i16 >> 2, pp = i16 & 3, c0 = ctile + 16 * ((lane >> 4) & 1) + 4 * pp;
    const s16x4v lo = __builtin_amdgcn_ds_read_tr16_b64_v4i16((LAS s16x4v*)(base + (rowA + q) * stride + c0));
    const s16x4v hi = __builtin_amdgcn_ds_read_tr16_b64_v4i16((LAS s16x4v*)(base + (rowB + q) * stride + c0));
    return __builtin_shufflevector(lo, hi, 0, 1, 2, 3, 4, 5, 6, 7);
}
__device__ __forceinline__ bf16x8v row_frag(const LAS bf16* base, int stride, int row, int k0) { return *(const LAS bf16x8v*)(base + row * stride + k0); }

__device__ __forceinline__ void ph_attn_mfma(const bf16* Q, const bf16* K, const bf16* V, const float* sinks, bf16* CAT, LAS unsigned char* lds, int bid, int nblk, int tid_in) {
    constexpr int KS = 72;
    LAS bf16* Ks = (LAS bf16*)lds; LAS bf16* Vs = Ks + 256 * KS;
    int tid = tid_in;
    const int lane = tid & 63, wave = __builtin_amdgcn_readfirstlane(tid >> 6), r = lane & 31, h = lane >> 5;
    for (int unit = bid; unit < BATCH * (SEQ / 128) * A_KV; unit += nblk) {
        const int b = unit >> 7, blk = (unit & 127) >> 2, kvh = unit & 3;
        const int m0 = b * SEQ + blk * 128;
        LDS_BARRIER();
        const int g = wave & 3, qh = wave >> 2, head = kvh * 4 + g;
        bf16x8v Qf[4], Qn[4];
#pragma unroll
        for (int kk = 0; kk < 4; ++kk) Qf[kk] = *(const bf16x8v*)(Q + (size_t)(m0 + qh * 64 + r) * A_WIDTH + head * HD + 16 * kk + 8 * h);
#pragma unroll
        for (int i = 0; i < 4; ++i) { const int c = tid + 512 * i, row = c >> 3, c8 = (c & 7) * 8;
            unsigned z0 = 0u; asm volatile("" : "+v"(z0));
            v4u kv = (v4u){z0, z0, z0, z0}, vv = kv;
            if (blk > 0 || row >= 128) { const size_t go = (size_t)(m0 - 128 + row) * KV_WIDTH + kvh * HD + c8; kv = *(const v4u*)(K + go); vv = *(const v4u*)(V + go); }
            *(LAS v4u*)(Ks + row * KS + c8) = kv; *(LAS v4u*)(Vs + row * KS + c8) = vv; }
        LDS_BARRIER();
        const float sink = sinks[head];
#pragma unroll 1
        for (int qt = 0; qt < 2; ++qt) {
            const int i0 = qh * 64 + qt * 32, kt0 = i0 >> 5, iq = i0 + r;
            if (qt == 0) {
#pragma unroll
                for (int kk = 0; kk < 4; ++kk) Qn[kk] = *(const bf16x8v*)(Q + (size_t)(m0 + qh * 64 + 32 + r) * A_WIDTH + head * HD + 16 * kk + 8 * h); }
            f32x16 S[5];
#pragma unroll
            for (int t = 0; t < 5; ++t) {
#pragma unroll
                for (int i = 0; i < 16; ++i) S[t][i] = 0.f;
#pragma unroll
                for (int kk = 0; kk < 4; ++kk) S[t] = MFMA32(row_frag(Ks, KS, 32 * (kt0 + t) + r, 16 * kk + 8 * h), Qf[kk], S[t]);
            }
            float mx = -1e30f;
#pragma unroll
            for (int t = 0; t < 5; ++t)
#pragma unroll
                for (int i = 0; i < 16; ++i) { const int j = 32 * (kt0 + t) + crow(i, h); const bool valid = (j >= iq + 1) && (j <= iq + 128) && (blk > 0 || j >= 128);
                    const float s = valid ? S[t][i] : -1e30f; S[t][i] = s; mx = fmaxf(mx, s); }
            mx = fmaxf(mx, __shfl_xor(mx, 32)); mx = fmaxf(mx, sink);
            float sum = 0.f;
#pragma unroll
            for (int t = 0; t < 5; ++t)
#pragma unroll
                for (int i = 0; i < 16; ++i) { const float p = __expf(S[t][i] - mx); S[t][i] = p; sum += p; }
            sum += __shfl_xor(sum, 32); sum += __expf(sink - mx);
            const float inv = 1.0f / sum;
            f32x16 O[2];
#pragma unroll
            for (int i = 0; i < 16; ++i) { O[0][i] = 0.f; O[1][i] = 0.f; }
#pragma unroll
            for (int t = 0; t < 5; ++t) {
#pragma unroll
                for (int i = 0; i < 16; ++i) S[t][i] *= inv;
#pragma unroll
                for (int sp = 0; sp < 2; ++sp) { const bf16x8v Af = pack8(S[t], sp); const int rowA = 32 * (kt0 + t) + 16 * sp + 4 * h;
#pragma unroll
                    for (int dt = 0; dt < 2; ++dt) O[dt] = MFMA32(Af, tr_frag(Vs, KS, rowA, rowA + 8, 32 * dt, lane), O[dt]); }
            }
#pragma unroll
            for (int dt = 0; dt < 2; ++dt)
#pragma unroll
                for (int i = 0; i < 16; ++i) CAT[(size_t)(m0 + i0 + crow(i, h)) * 2048 + head * HD + 32 * dt + r] = (bf16)(pkbf(O[dt][i], 0.f) & 0xffffu);
#pragma unroll
            for (int kk = 0; kk < 4; ++kk) Qf[kk] = Qn[kk];
        }
    }
    LDS_BARRIER();
}

__device__ __forceinline__ void ph_ssd_mfma(const bf16* XBCC, const float* DT, const bf16* Z, const float* a_log, const float* d_skip, bf16* YG, float* SSG, LAS unsigned char* lds, int bid, int nblk, int tid_in) {
    constexpr int BS = 136, XS = 72;
    LAS bf16* Bs = (LAS bf16*)lds;
    LAS bf16* Cs = Bs + 128 * BS;
    LAS bf16* xs = Cs + 128 * BS;
    LAS bf16* xw = xs + 128 * XS;
    LAS bf16* Sb = xw + 128 * XS;
    LAS float* acum = (LAS float*)(Sb + 64 * BS);
    LAS float* dl = acum + 128;
    LAS float* wsd = dl + 128;
    LAS float* dtv = wsd + 128;
    constexpr int YS = 68;
    LAS float* ybuf = dtv + 128;
    LAS float* fsv = ybuf + 128 * YS;
    int tid = tid_in;
    const int lane = tid & 63, wave = __builtin_amdgcn_readfirstlane(tid >> 6), r = lane & 31, h = lane >> 5;
    const int orow = tid >> 2, ocg = (tid & 3) * 16;
    const int li = (int)((0x11002233u >> (4 * wave)) & 15u), hf = (int)((0x5Au >> wave) & 1u);
    const int sp_t = wave >> 2, sn_t = wave & 3;
    for (int unit = bid; unit < BATCH * M_HEADS; unit += nblk) {
        const int gg = (unit & 7) * 4 + (unit >> 6), b = gg >> 3, grp = gg & 7, hd = grp * 8 + ((unit >> 3) & 7); const float a = -expf(a_log[hd]), Dh = d_skip[hd];
        f32x16 Sacc;
#pragma unroll
        for (int i = 0; i < 16; ++i) Sacc[i] = 0.f;
        LDS_BARRIER();
        { unsigned on3 = ~0u; asm volatile("" : "+s"(on3));
          const int tz = wave * 64 + (int)__builtin_amdgcn_mbcnt_hi(on3, __builtin_amdgcn_mbcnt_lo(on3, 0u));
          for (int i = tz; i < 64 * BS / 2; i += 512) ((LAS unsigned*)Sb)[i] = 0u; }
        v4u nb[4], nc[4], nx[2]; float nd0, nd1;
        { const int m0 = b * SEQ;
#pragma unroll
          for (int i = 0; i < 4; ++i) { const int c = tid + 512 * i, row = c >> 4, c8 = (c & 15) * 8; const size_t go = (size_t)(m0 + row) * M_CONV_DIM + 4096 + grp * 128 + c8; nb[i] = *(const v4u*)(XBCC + go); nc[i] = *(const v4u*)(XBCC + go + 1024); }
#pragma unroll
          for (int i = 0; i < 2; ++i) { const int c = tid + 512 * i, row = c >> 3, c8 = (c & 7) * 8; nx[i] = *(const v4u*)(XBCC + (size_t)(m0 + row) * M_CONV_DIM + hd * 64 + c8); }
          nd0 = DT[(size_t)(m0 + 2 * lane) * 64 + hd]; nd1 = DT[(size_t)(m0 + 2 * lane + 1) * 64 + hd]; }
#pragma unroll 1
        for (int chunk = 0; chunk < SEQ / 128; ++chunk) {
            const int m0 = b * SEQ + chunk * 128;
#pragma unroll
            for (int i = 0; i < 4; ++i) { const int c = tid + 512 * i, row = c >> 4, c8 = (c & 15) * 8; *(LAS v4u*)(Bs + row * BS + c8) = nb[i]; *(LAS v4u*)(Cs + row * BS + c8) = nc[i]; }
            { const float d0 = nd0, d1 = nd1; const float v0 = a * d0, v1 = a * d1; float sc = v0 + v1;
#pragma unroll
              for (int o = 1; o < 64; o <<= 1) { const float t = __shfl_up(sc, o); if (lane >= o) sc += t; }
              const float c1 = sc, c0 = sc - v1; const float tot = __shfl(sc, 63);
              *(LAS f32x2v*)(acum + 2 * lane) = (f32x2v){c0, c1}; *(LAS f32x2v*)(dl + 2 * lane) = (f32x2v){__expf(c0), __expf(c1)};
              *(LAS f32x2v*)(wsd + 2 * lane) = (f32x2v){d0 * __expf(tot - c0), d1 * __expf(tot - c1)}; *(LAS f32x2v*)(dtv + 2 * lane) = (f32x2v){d0, d1};
              const float ce = __shfl(c1, lane | 15);
              *(LAS f32x2v*)(fsv + 2 * lane) = (f32x2v){d0 * __expf(ce - c0), d1 * __expf(ce - c1)}; }
#pragma unroll
            for (int i = 0; i < 2; ++i) { const int c = tid + 512 * i, row = c >> 3, c8 = (c & 7) * 8; const v4u w = nx[i]; const float f = wsd[row];
                *(LAS v4u*)(xs + row * XS + c8) = w;
                v4u o; o.x = pkbf(blo(w.x) * f, bhi(w.x) * f); o.y = pkbf(blo(w.y) * f, bhi(w.y) * f); o.z = pkbf(blo(w.z) * f, bhi(w.z) * f); o.w = pkbf(blo(w.w) * f, bhi(w.w) * f);
                *(LAS v4u*)(xw + row * XS + c8) = o; }
            if (chunk + 1 < SEQ / 128) { const int m1 = m0 + 128;
#pragma unroll
                for (int i = 0; i < 4; ++i) { const int c = tid + 512 * i, row = c >> 4, c8 = (c & 15) * 8; const size_t go = (size_t)(m1 + row) * M_CONV_DIM + 4096 + grp * 128 + c8; nb[i] = *(const v4u*)(XBCC + go); nc[i] = *(const v4u*)(XBCC + go + 1024); }
#pragma unroll
                for (int i = 0; i < 2; ++i) { const int c = tid + 512 * i, row = c >> 3, c8 = (c & 7) * 8; nx[i] = *(const v4u*)(XBCC + (size_t)(m1 + row) * M_CONV_DIM + hd * 64 + c8); }
                nd0 = DT[(size_t)(m1 + 2 * lane) * 64 + hd]; nd1 = DT[(size_t)(m1 + 2 * lane + 1) * 64 + hd]; }
            LDS_BARRIER();
            v4u zr[2];
            { const bf16* zp = Z + (size_t)(m0 + orow) * M_INNER + hd * 64 + ocg; zr[0] = *(const v4u*)zp; zr[1] = *(const v4u*)(zp + 8); }
            f32x16 acc[2];
#pragma unroll
            for (int i = 0; i < 16; ++i) { acc[0][i] = 0.f; acc[1][i] = 0.f; }
            {
                f32x16 a2;
#pragma unroll
                for (int i = 0; i < 16; ++i) a2[i] = 0.f;
#pragma unroll
                for (int kh = 0; kh < 2; ++kh) {
                    bf16x8v Cf[4], Xf[4];
#pragma unroll
                    for (int kk = 0; kk < 4; ++kk) { Cf[kk] = row_frag(Cs, BS, 32 * li + r, 64 * kh + 16 * kk + 8 * h); Xf[kk] = row_frag(Sb, BS, 32 * hf + r, 64 * kh + 16 * kk + 8 * h); }
                    __builtin_amdgcn_sched_barrier(0);
#pragma unroll
                    for (int kk = 0; kk < 4; ++kk) a2 = MFMA32(Cf[kk], Xf[kk], a2);
                }
#pragma unroll
                for (int i = 0; i < 16; ++i) { const int l = 32 * li + crow(i, h); a2[i] = a2[i] * dl[l] + Dh * bf2f(xs[l * XS + 32 * hf + r]); }
                if (hf) acc[1] = a2; else acc[0] = a2;
            }
            const int lcol = 32 * li + r; const float al = acum[lcol];
#pragma unroll 1
            for (int j = hf; j <= li; j += 2) {
                f32x16 T;
#pragma unroll
                for (int i = 0; i < 16; ++i) T[i] = 0.f;
#pragma unroll
                for (int kh = 0; kh < 2; ++kh) {
                    bf16x8v Cf[4], Xf[4];
#pragma unroll
                    for (int kk = 0; kk < 4; ++kk) { Xf[kk] = row_frag(Bs, BS, 32 * j + r, 64 * kh + 16 * kk + 8 * h); Cf[kk] = row_frag(Cs, BS, 32 * li + r, 64 * kh + 16 * kk + 8 * h); }
                    __builtin_amdgcn_sched_barrier(0);
#pragma unroll
                    for (int kk = 0; kk < 4; ++kk) T = MFMA32(Xf[kk], Cf[kk], T);
                }
                if (j < li) {
                    const float fl = __expf(al - acum[32 * j + 31]);
#pragma unroll
                    for (int q = 0; q < 4; ++q) { const f32x4 f4 = *(const LAS f32x4*)(fsv + 32 * j + 4 * h + 8 * q);
#pragma unroll
                        for (int k = 0; k < 4; ++k) T[4 * q + k] *= f4[k] * fl; }
                } else {
#pragma unroll
                    for (int q = 0; q < 4; ++q) { const f32x4 ac4 = *(const LAS f32x4*)(acum + 32 * j + 4 * h + 8 * q), dt4 = *(const LAS f32x4*)(dtv + 32 * j + 4 * h + 8 * q);
#pragma unroll
                        for (int k = 0; k < 4; ++k) { const int s = 32 * j + 8 * q + 4 * h + k; const float e = __expf(fminf(al - ac4[k], 0.f)) * dt4[k]; T[4 * q + k] *= (s <= lcol) ? e : 0.f; } }
                }
                const bf16x8v pa0 = pack8(T, 0), pa1 = pack8(T, 1); const int rowA = 32 * j + 4 * h;
#pragma unroll
                for (int pp = 0; pp < 2; ++pp) { const bf16x8v x0 = tr_frag(xs, XS, rowA, rowA + 8, 32 * pp, lane), x1 = tr_frag(xs, XS, rowA + 16, rowA + 24, 32 * pp, lane);
                    acc[pp] = MFMA32(pa0, x0, acc[pp]); acc[pp] = MFMA32(pa1, x1, acc[pp]); }
            }
            if (hf == 0) {
#pragma unroll
                for (int pp = 0; pp < 2; ++pp)
#pragma unroll
                    for (int i = 0; i < 16; ++i) ybuf[(32 * li + crow(i, h)) * YS + 32 * pp + r] = acc[pp][i];
            }
            { const float dtot = dl[127];
#pragma unroll
              for (int i = 0; i < 16; ++i) Sacc[i] *= dtot;
#pragma unroll
              for (int kh = 0; kh < 2; ++kh) { bf16x8v Af[4], Bf[4];
#pragma unroll
                  for (int kk = 0; kk < 4; ++kk) { const int rowA = 64 * kh + 16 * kk + 8 * h; Af[kk] = tr_frag(xw, XS, rowA, rowA + 4, 32 * sp_t, lane); Bf[kk] = tr_frag(Bs, BS, rowA, rowA + 4, 32 * sn_t, lane); }
                  __builtin_amdgcn_sched_barrier(0);
#pragma unroll
                  for (int kk = 0; kk < 4; ++kk) Sacc = MFMA32(Af[kk], Bf[kk], Sacc); } }
            LDS_BARRIER();
            if (hf == 1) {
#pragma unroll
                for (int pp = 0; pp < 2; ++pp)
#pragma unroll
                    for (int i = 0; i < 16; ++i) { LAS float* q = ybuf + (32 * li + crow(i, h)) * YS + 32 * pp + r; *q = *q + acc[pp][i]; }
            }
            LDS_BARRIER();
#pragma unroll
            for (int i = 0; i < 16; ++i) Sb[(32 * sp_t + crow(i, h)) * BS + 32 * sn_t + r] = (bf16)(pkbf(Sacc[i], 0.f) & 0xffffu);
            { const LAS f32x4* yp = (const LAS f32x4*)(ybuf + orow * YS + ocg);
              bf16* op = YG + ((size_t)(((m0 + orow) >> 8) * M_HEADS + hd) * 256 + ((m0 + orow) & 255)) * 64 + ocg;
              float qs = 0.f;
#pragma unroll
              for (int q = 0; q < 2; ++q) { const f32x4 y0 = yp[2 * q], y1 = yp[2 * q + 1]; const v4u zw = zr[q];
                  const float g0 = y0.x * siluf_(blo(zw.x)), g1 = y0.y * siluf_(bhi(zw.x)), g2 = y0.z * siluf_(blo(zw.y)), g3 = y0.w * siluf_(bhi(zw.y));
                  const float g4 = y1.x * siluf_(blo(zw.z)), g5 = y1.y * siluf_(bhi(zw.z)), g6 = y1.z * siluf_(blo(zw.w)), g7 = y1.w * siluf_(bhi(zw.w));
                  qs += ((g0 * g0 + g1 * g1) + (g2 * g2 + g3 * g3)) + ((g4 * g4 + g5 * g5) + (g6 * g6 + g7 * g7));
                  v4u o; o.x = pkbf(g0, g1); o.y = pkbf(g2, g3); o.z = pkbf(g4, g5); o.w = pkbf(g6, g7);
                  *(v4u*)(op + 8 * q) = o; }
              qs += __shfl_xor(qs, 1); qs += __shfl_xor(qs, 2);
              if ((tid & 3) == 0) SSG[(size_t)(m0 + orow) * 64 + hd] = qs; }
        }
    }
    LDS_BARRIER();
}

__device__ __forceinline__ void ph_s5_mfma(const CAS Params* PP, int e, const bf16* U, bf16* G, LAS unsigned char* lds, int bid, int nblk, int tid_in) {
    constexpr int BU = 132, HS = 136;
    LAS float* bu = (LAS float*)lds;
    LAS bf16* hs = (LAS bf16*)(bu + 2 * 64 * BU);
    int tid = tid_in;
    const int lane = tid & 63, wave = __builtin_amdgcn_readfirstlane(tid >> 6), r = lane & 31, h = lane >> 5;
    const float* a_re = ((const float*)(const GAS float*)PP->in[I_ARE]) + (size_t)e * 64 * 64; const float* a_im = ((const float*)(const GAS float*)PP->in[I_AIM]) + (size_t)e * 64 * 64;
    const float* log_dt = ((const float*)(const GAS float*)PP->in[I_LOGDT]) + (size_t)e * 64;
    const float* b_re = ((const float*)(const GAS float*)PP->in[I_BRE]) + (size_t)e * 64 * 64 * 16; const float* b_im = ((const float*)(const GAS float*)PP->in[I_BIM]) + (size_t)e * 64 * 64 * 16;
    const float* c_re = ((const float*)(const GAS float*)PP->in[I_CRE]) + (size_t)e * 64 * 16 * 64; const float* c_im = ((const float*)(const GAS float*)PP->in[I_CIM]) + (size_t)e * 64 * 16 * 64;
    const float* d_skip = ((const float*)(const GAS float*)PP->in[I_S5D]) + (size_t)e * 1024;
    for (int unit = bid; unit < BATCH * S5_GROUPS; unit += nblk) {
        const int b = unit >> 6, g = unit & 63; const float dt = expf(log_dt[g]);
        LDS_BARRIER();
        if (wave == 1 || wave == 2) {
            bf16x8v Bf[4];
#pragma unroll
            for (int kt = 0; kt < 4; ++kt) { const int k = 32 * kt + r, p = k >> 1, ri = k & 1;
                const float ar = a_re[g * 64 + p], ai = a_im[g * 64 + p]; const float mag = expf(ar * dt), abr = mag * cosf(ai * dt), abi = mag * sinf(ai * dt);
                const float nr = abr - 1.0f, ni = abi, den = ar * ar + ai * ai; const float cr = (nr * ar + ni * ai) / den, ci = (ni * ar - nr * ai) / den;
                float v[8];
#pragma unroll
                for (int j = 0; j < 8; ++j) { const float br = b_re[(size_t)(g * 64 + p) * 16 + 8 * h + j], bi = b_im[(size_t)(g * 64 + p) * 16 + 8 * h + j]; v[j] = ri ? (cr * bi + ci * br) : (cr * br - ci * bi); }
                v4u w; w.x = pkbf(v[0], v[1]); w.y = pkbf(v[2], v[3]); w.z = pkbf(v[4], v[5]); w.w = pkbf(v[6], v[7]); Bf[kt] = __builtin_bit_cast(bf16x8v, w); }
            const int tt = wave - 1;
            bf16x8v un = *(const bf16x8v*)(U + (size_t)(b * SEQ + 32 * tt + r) * S5_WIDTH + g * 16 + 8 * h);
#pragma unroll 1
            for (int i = 0; i < SEQ / 64 + 2; ++i) {
                if (i < SEQ / 64) {
                    const bf16x8v uc = un;
                    if (i + 1 < SEQ / 64) un = *(const bf16x8v*)(U + (size_t)(b * SEQ + (i + 1) * 64 + 32 * tt + r) * S5_WIDTH + g * 16 + 8 * h);
                    LAS float* dst = bu + (i & 1) * 64 * BU;
#pragma unroll
                    for (int kt = 0; kt < 4; ++kt) { f32x16 z;
#pragma unroll
                        for (int q = 0; q < 16; ++q) z[q] = 0.f;
                        const f32x16 d = MFMA32(uc, Bf[kt], z);
#pragma unroll
                        for (int q = 0; q < 16; ++q) dst[(32 * tt + crow(q, h)) * BU + 32 * kt + r] = d[q]; }
                }
                LDS_BARRIER();
            }
        } else if (wave == 0) {
            const int p = lane; const float ar = a_re[g * 64 + p], ai = a_im[g * 64 + p]; const float mag = expf(ar * dt), abr = mag * cosf(ai * dt), abi = mag * sinf(ai * dt);
            typedef float f2 __attribute__((ext_vector_type(2)));
            f2 hv = {0.f, 0.f}; const f2 av = {abr, abr}, bv = {-abi, abi};
#pragma unroll 1
            for (int i = 0; i < SEQ / 64 + 2; ++i) {
                if (i >= 1 && i <= SEQ / 64) {
                    const LAS float* src = bu + ((i - 1) & 1) * 64 * BU + 2 * p;
                    unsigned da = (unsigned)(size_t)(hs + ((i - 1) & 1) * 64 * HS + 2 * p); asm volatile("" : "+v"(da)); LAS bf16* dst = (LAS bf16*)(size_t)da;
                    f2 ba[16], bc[16];
#define S5_LD(arr, T0) _Pragma("unroll") for (int j = 0; j < 16; ++j) arr[j] = *(const LAS f2*)(src + ((T0) + j) * BU)
#define S5_PROC(arr, T0) _Pragma("unroll") for (int j = 0; j < 16; ++j) { const f2 sw = __builtin_shufflevector(hv, hv, 1, 0); const f2 t = __builtin_elementwise_fma(bv, sw, arr[j]); hv = __builtin_elementwise_fma(av, hv, t); \
                            *(LAS unsigned*)(dst + ((T0) + j) * HS) = pkbf(hv.x, hv.y); }
                    S5_LD(ba, 0); S5_LD(bc, 16); __builtin_amdgcn_sched_barrier(0);
                    S5_PROC(ba, 0); __builtin_amdgcn_sched_barrier(0); S5_LD(ba, 32); __builtin_amdgcn_sched_barrier(0);
                    S5_PROC(bc, 16); __builtin_amdgcn_sched_barrier(0); S5_LD(bc, 48); __builtin_amdgcn_sched_barrier(0);
                    S5_PROC(ba, 32); __builtin_amdgcn_sched_barrier(0);
                    S5_PROC(bc, 48);
#undef S5_LD
#undef S5_PROC
                }
                LDS_BARRIER();
            }
        } else if (wave == 3 || wave == 6) {
            bf16x8v Cf[8];
#pragma unroll
            for (int kk = 0; kk < 8; ++kk) { float v[8];
#pragma unroll
                for (int j = 0; j < 8; ++j) { const int k = 16 * kk + 8 * h + j, p = k >> 1; v[j] = (r < 16) ? ((k & 1) ? -c_im[(size_t)(g * 16 + (r & 15)) * 64 + p] : c_re[(size_t)(g * 16 + (r & 15)) * 64 + p]) : 0.f; }
                v4u w; w.x = pkbf(v[0], v[1]); w.y = pkbf(v[2], v[3]); w.z = pkbf(v[4], v[5]); w.w = pkbf(v[6], v[7]); Cf[kk] = __builtin_bit_cast(bf16x8v, w); }
            const int tt = (wave == 6) ? 1 : 0; const float dsk = d_skip[g * 16 + (r & 15)];
            unsigned short un[16];
#pragma unroll
            for (int q = 0; q < 16; ++q) un[q] = U[(size_t)(b * SEQ + 32 * tt + crow(q, h)) * S5_WIDTH + g * 16 + (r & 15)];
#pragma unroll 1
            for (int i = 0; i < SEQ / 64 + 2; ++i) {
                if (i >= 2) {
                    const int ch = i - 2; const LAS bf16* src = hs + (ch & 1) * 64 * HS; const int m0 = b * SEQ + ch * 64 + 32 * tt;
                    float uv[16];
#pragma unroll
                    for (int q = 0; q < 16; ++q) uv[q] = bf2f(un[q]);
                    if (ch + 1 < SEQ / 64) {
#pragma unroll
                        for (int q = 0; q < 16; ++q) un[q] = U[(size_t)(m0 + 64 + crow(q, h)) * S5_WIDTH + g * 16 + (r & 15)];
                    }
                    bf16x8v hf[8];
#pragma unroll
                    for (int kk = 0; kk < 8; ++kk) hf[kk] = row_frag(src, HS, 32 * tt + r, 16 * kk + 8 * h);
                    __builtin_amdgcn_sched_barrier(0);
                    f32x16 y;
#pragma unroll
                    for (int q = 0; q < 16; ++q) y[q] = 0.f;
#pragma unroll
                    for (int kk = 0; kk < 8; ++kk) y = MFMA32(hf[kk], Cf[kk], y);
                    if (r < 16) {
#pragma unroll
                        for (int q = 0; q < 16; ++q) G[(size_t)(m0 + crow(q, h)) * S5_WIDTH + g * 16 + r] = (bf16)(pkbf(gelu_tanh(y[q] + dsk * uv[q]), 0.f) & 0xffffu);
                    }
                }
                LDS_BARRIER();
            }
        } else {
#pragma unroll 1
            for (int i = 0; i < SEQ / 64 + 2; ++i) LDS_BARRIER();
        }
    }
    LDS_BARRIER();
}

struct CvtItem { const float* src; bf16* dst; const float* g; int N, K, il, off, tiled, kb; };
__device__ __forceinline__ void cvt_load(f32x4 (&v)[16], float (&gk)[16], const CvtItem& it, int lane) {
    const float* p = it.src + (size_t)(lane >> 4) * it.N + 4 * (lane & 15);
#pragma unroll
    for (int i = 0; i < 16; ++i) v[i] = *(const f32x4*)(p + (size_t)(4 * i) * it.N);
    if (it.g) {
#pragma unroll
        for (int i = 0; i < 16; ++i) gk[i] = it.g[4 * i + (lane >> 4)];
    } else {
#pragma unroll
        for (int i = 0; i < 16; ++i) gk[i] = 1.0f;
    }
}
__device__ __forceinline__ void cvt_process(const f32x4 (&v)[16], const float (&gk)[16], const CvtItem& it, int n0, LAS bf16* T1, LAS bf16* T2, int lane, int nostore = 0) {
    constexpr int TS = 72;
#pragma unroll
    for (int i = 0; i < 16; ++i) { v2u w; w.x = pkbf(v[i].x * gk[i], v[i].y * gk[i]); w.y = pkbf(v[i].z * gk[i], v[i].w * gk[i]); *(LAS v2u*)(T1 + (4 * i + (lane >> 4)) * TS + 4 * (lane & 15)) = w; }
    const int i16 = lane & 15, q = i16 >> 2, pp = i16 & 3, g = lane >> 4;
#pragma unroll
    for (int c = 0; c < 8; ++c) {
        const s16x4v lo = __builtin_amdgcn_ds_read_tr16_b64_v4i16((LAS s16x4v*)(T1 + (8 * c + q) * TS + 16 * g + 4 * pp));
        const s16x4v hi = __builtin_amdgcn_ds_read_tr16_b64_v4i16((LAS s16x4v*)(T1 + (8 * c + 4 + q) * TS + 16 * g + 4 * pp));
        *(LAS bf16x8v*)(T2 + lane * TS + 8 * c) = __builtin_shufflevector(lo, hi, 0, 1, 2, 3, 4, 5, 6, 7);
    }
#pragma unroll
    for (int t = 0; t < 8; ++t) { const int n = 8 * t + (lane >> 3), c = lane & 7; const v4u o = *(const LAS v4u*)(T2 + n * TS + 8 * c);
        const int nn = n0 + n; const int row = it.il ? ((nn >> 7) * 256 + (nn & 127) + it.off) : nn;
        bf16* p = it.tiled ? it.dst + ((size_t)((row >> 8) * (it.K >> 6) + it.kb) * 256 + (row & 255)) * 64 + 8 * c
                           : it.dst + (size_t)row * it.K + 64 * it.kb + 8 * c;
        if (!nostore || o.x == 0x12345678u) *(v4u*)p = o; }
}
__device__ __forceinline__ void ph_convert(const CAS Params* PP, int L, unsigned char* Wb, LAS unsigned char* lds, int gw, int NGW, int lane, int wave, int nostore = 0) {
    LAS bf16* T1 = (LAS bf16*)(lds + wave * 18432); LAS bf16* T2 = T1 + 64 * 72;
    const size_t fo = (size_t)L * D_MODEL * D_FF; const int eo = L >> 1; const bool even = (L & 1) == 0;
    constexpr int NF = 2816;
    const int n_mix = even ? (1280 + 256 + 1024) : (5152 + 2048);
    const int total = 6 * NF + n_mix;
    auto pick = [&](int idx, CvtItem& d, int& n0) {
        const float* W; bf16* WT; const float* gv = nullptr; int K, N, il = 0, off = 0, rel, tiled = 1;
        if (idx < 6 * NF) { const int mi = idx / NF; rel = idx - mi * NF;
            const int which = mi / 3, t = mi - 3 * which;
            if (t == 2) { W = (const float*)(const GAS float*)PP->in[which ? I_F2D : I_F1D] + fo; WT = (bf16*)(Wb + (which ? W_D1 : W_D0)); K = D_FF; N = D_MODEL; tiled = 1; }
            else { W = (const float*)(const GAS float*)PP->in[which ? (t ? I_F2U : I_F2G) : (t ? I_F1U : I_F1G)] + fo; WT = (bf16*)(Wb + (which ? W_GU1 : W_GU0)); K = D_MODEL; N = D_FF; il = 1; off = t ? 128 : 0;
                   gv = (const float*)(const GAS float*)PP->in[which ? I_NFFN2 : I_NFFN1] + (size_t)L * D_MODEL; }
        } else { rel = idx - 6 * NF;
            if (even) {
                if (rel < 1280) { W = (const float*)(const GAS float*)PP->in[I_EWIN] + (size_t)eo * D_MODEL * EVEN_IN; WT = (bf16*)(Wb + W_EIN); K = D_MODEL; N = EVEN_IN; gv = (const float*)(const GAS float*)PP->in[I_NMIX] + (size_t)L * D_MODEL; }
                else if (rel < 1280 + 256) { rel -= 1280; W = (const float*)(const GAS float*)PP->in[I_WGLU] + (size_t)eo * 1024 * 1024; WT = (bf16*)(Wb + W_EGLU); K = 1024; N = 1024; }
                else { rel -= 1280 + 256; W = (const float*)(const GAS float*)PP->in[I_EWOUT] + (size_t)eo * 2048 * 2048; WT = (bf16*)(Wb + W_EOUT); K = 2048; N = 2048; }
            } else {
                if (rel < 5152) { W = (const float*)(const GAS float*)PP->in[I_MWIN] + (size_t)eo * D_MODEL * M_IN; WT = (bf16*)(Wb + W_OIN); K = D_MODEL; N = M_IN; gv = (const float*)(const GAS float*)PP->in[I_NMIX] + (size_t)L * D_MODEL; }
                else { rel -= 5152; W = (const float*)(const GAS float*)PP->in[I_MWOUT] + (size_t)eo * M_INNER * D_MODEL; WT = (bf16*)(Wb + W_OOUT); K = M_INNER; N = D_MODEL; gv = (const float*)(const GAS float*)PP->in[I_MNORM] + (size_t)eo * M_INNER; }
            }
        }
        const int nblk = N >> 6, kb = rel / nblk, nb = rel - kb * nblk;
        d.src = W + (size_t)(64 * kb) * N + 64 * nb; d.dst = WT; d.tiled = tiled; d.kb = kb; d.N = N; d.K = K; d.il = il; d.off = off; d.g = gv ? gv + 64 * kb : nullptr; n0 = 64 * nb;
    };
    f32x4 va[16], vb[16]; float ga[16], gb[16]; CvtItem da, db; int na = 0, nbn = 0;
    int idx = gw;
    if (idx < total) { pick(idx, da, na); cvt_load(va, ga, da, lane); }
    while (idx < total) {
        const int i1 = idx + NGW, i2 = idx + 2 * NGW;
        if (i1 < total) { pick(i1, db, nbn); cvt_load(vb, gb, db, lane); }
        cvt_process(va, ga, da, na, T1, T2, lane, nostore);
        if (i1 < total) {
            if (i2 < total) { pick(i2, da, na); cvt_load(va, ga, da, lane); }
            cvt_process(vb, gb, db, nbn, T1, T2, lane, nostore);
        }
        idx = i2;
    }
}

__device__ __forceinline__ void ph_dt_mini(const bf16* XB, const bf16* Wdt, const float* SS, float* DT, LAS unsigned char* lds, int bid, int nblk, int tid_in) {
    constexpr int PS = 68;
    LAS float* part = (LAS float*)lds;
    int tid = tid_in;
    const int lane = tid & 63, wave = __builtin_amdgcn_readfirstlane(tid >> 6), r = lane & 31, h = lane >> 5;
    for (int job = bid; job < M_TOK / 64; job += nblk) {
        const int R0 = job * 64;
        const bf16* ap = XB + ((size_t)((R0 >> 8) * 32) * 256 + (R0 & 255) + r) * 64 + 8 * h;
        const bf16* bp = Wdt + (size_t)r * 64 + 8 * h;
        f32x16 acc[2][2];
#pragma unroll
        for (int i = 0; i < 16; ++i) { acc[0][0][i] = 0.f; acc[0][1][i] = 0.f; acc[1][0][i] = 0.f; acc[1][1][i] = 0.f; }
#pragma unroll 1
        for (int q = 0; q < 4; ++q) { const size_t ko = (size_t)(4 * wave + q) * 16384;
            bf16x8v af[4][2], bf[4][2];
#pragma unroll
            for (int ks = 0; ks < 4; ++ks)
#pragma unroll
                for (int t = 0; t < 2; ++t) { af[ks][t] = *(const bf16x8v*)(ap + ko + t * 2048 + ks * 16); bf[ks][t] = *(const bf16x8v*)(bp + ko + t * 2048 + ks * 16); }
#pragma unroll
            for (int ks = 0; ks < 4; ++ks)
#pragma unroll
                for (int rt = 0; rt < 2; ++rt)
#pragma unroll
                    for (int ct = 0; ct < 2; ++ct) acc[rt][ct] = MFMA32(af[ks][rt], bf[ks][ct], acc[rt][ct]);
        }
        LDS_BARRIER();
#pragma unroll
        for (int rt = 0; rt < 2; ++rt)
#pragma unroll
            for (int ct = 0; ct < 2; ++ct)
#pragma unroll
                for (int i = 0; i < 16; ++i) part[(wave * 64 + 32 * rt + crow(i, h)) * PS + 32 * ct + r] = acc[rt][ct][i];
        LDS_BARRIER();
        { const int row = tid >> 3, c8 = (tid & 7) * 8; f32x4 s0 = *(const LAS f32x4*)(part + row * PS + c8), s1 = *(const LAS f32x4*)(part + row * PS + c8 + 4);
#pragma unroll
          for (int w = 1; w < 8; ++w) { s0 += *(const LAS f32x4*)(part + (w * 64 + row) * PS + c8); s1 += *(const LAS f32x4*)(part + (w * 64 + row) * PS + c8 + 4); }
          const f32x4 sp = *(const f32x4*)(SS + (size_t)(R0 + row) * 32 + 4 * (tid & 7)); float t = (sp[0] + sp[1]) + (sp[2] + sp[3]);
          t += __shfl_xor(t, 1); t += __shfl_xor(t, 2); t += __shfl_xor(t, 4);
          const float sc = __builtin_amdgcn_rsqf(t * (1.0f / 2048.0f) + 1e-5f);
          float* op = DT + (size_t)(R0 + row) * 64 + c8; *(f32x4*)op = s0 * sc; *(f32x4*)(op + 4) = s1 * sc; }
    }
    LDS_BARRIER();
}
constexpr int NPH = 37 + 8 * ((PROBE_MASK >> 3) & 1) + 8 * ((PROBE_MASK >> 4) & 1) + 4 * ((PROBE_MASK >> 5) & 1) + 6 * ((PROBE_MASK >> 8) & 1) + 40 * ((PROBE_MASK >> 18) & 1);
__global__ void __launch_bounds__(512, 2) k_fwd(Params P) {
    extern __shared__ __attribute__((aligned(16))) unsigned char lds_raw[];
    LAS unsigned char* lds = (LAS unsigned char*)lds_raw;
    unsigned char* ws = P.ws;
    volatile LAS unsigned* MISC = (volatile LAS unsigned*)(lds + MISC_OFF);
    const int WV = __builtin_amdgcn_readfirstlane((int)threadIdx.x >> 6);
    if (threadIdx.x < 16) MISC[threadIdx.x] = 0u;
    __syncthreads();
    XcdBarrier bar; bar.bar = (unsigned*)(ws + WS_CTL) + CW_BAR; bar.x = 0; bar.st = MISC; bar.lead = false;
    if (P.hi - P.lo > 1) bar = xcd_barrier_post((unsigned*)(ws + WS_CTL) + CW_BAR, MISC);
    int ph = 0;
#define PH_BEGIN if (ph >= P.lo && ph < P.hi) { unsigned ones = ~0u; asm volatile("" : "+s"(ones)); int tid = WV * 64 + (int)__builtin_amdgcn_mbcnt_hi(ones, __builtin_amdgcn_mbcnt_lo(ones, 0u)); int bid = blockIdx.x, G = gridDim.x; asm volatile("" : "+s"(bid), "+s"(G)); \
    const int lane = tid & 63, wave = __builtin_amdgcn_readfirstlane(tid >> 6), gw = bid * 8 + wave, gtid = bid * 512 + tid, NGW = G * 8, gthreads = G * 512; (void)lane; (void)gw; (void)gtid; (void)NGW; (void)gthreads; \
    const CAS Params* PP = (const CAS Params*)__builtin_amdgcn_kernarg_segment_ptr(); asm volatile("" : "+s"(PP)); unsigned char* ws = (unsigned char*)(GAS unsigned char*)PP->ws; \
    float* X = (float*)(ws + WS_X); bf16* XN = (bf16*)(ws + WS_XN); float* ROT = (float*)(ws + WS_ROT); unsigned char* R = ws + WS_R; unsigned char* Wb = ws + WS_W; float* SSb = (float*)(ws + WS_SS); (void)SSb; float* SSGb = (float*)(ws + WS_SSG); (void)SSGb; float* DUMMY = (float*)(ws + WS_END); (void)X; (void)XN; (void)ROT; (void)R; (void)Wb; (void)DUMMY;
#define PH_END   if (ph + 1 < P.hi) { XcdBarrier bb = bar; unsigned boff = CW_BAR; asm volatile("" : "+s"(boff)); bb.bar = (unsigned*)(P.ws + WS_CTL) + boff; unsigned on2 = ~0u; asm volatile("" : "+s"(on2)); bb.lead = (WV == 0) && (__builtin_amdgcn_mbcnt_hi(on2, __builtin_amdgcn_mbcnt_lo(on2, 0u)) == 0u); xcd_barrier(bb); } } ++ph;
#define REP_BEGIN(kind) for (int rep = ((PROBE_MASK >> (kind)) & 1) ? 0 : 1; rep < 2; ++rep) {
#define REP_END }
#define INF(i) ((const float*)(const GAS float*)PP->in[i])
#define OUTP ((float*)(GAS float*)PP->out)

#define Qb ((bf16*)(R + R_Q))
#define Kb ((bf16*)(R + R_K))
#define Vb ((bf16*)(R + R_V))
#define Ub ((bf16*)(R + R_U))
#define Gb ((bf16*)(R + R_G))
#define CATb ((bf16*)(R + R_CAT))
#define Zb ((bf16*)(R + R_Z))
#define XBCb ((bf16*)(R + R_XBC))
#define XBCCb ((bf16*)(R + R_XBCC))
#define YGb ((bf16*)(R + R_YG))
#define YNb ((bf16*)(R + R_YN))
#define DTb ((float*)(R + R_DT))

#pragma unroll 1
    for (int fi = 0; fi < 2 * DEPTH; ++fi) {
        const int L = fi >> 1, which = fi & 1;
        if (which == 0) {
            PH_BEGIN
                if (L == 0) {
                    const int* pos = (const int*)(const GAS int*)PP->in[I_POS];
                    for (int i = gtid; i < M_TOK * 8; i += gthreads) { const int m = i >> 3, j = i & 7; float a = -13.122363377404328f * (float)j; a = a * 0.125f; const float ang = (float)pos[m] * expf(a);
                        ROT[m * 16 + j] = cosf(ang); ROT[m * 16 + 8 + j] = sinf(ang); }
                    ph_xb_ss(INF(I_X), XN, SSb, gw, NGW, lane);
                }
                REP_BEGIN(1)
                ph_convert(PP, L, Wb, lds, gw, NGW, lane, wave, (PROBE_MASK & 0x10000) ? (rep == 0) : 0);
                if ((L & 1) == 1) {
                    { unsigned z0 = 0u; asm volatile("" : "+v"(z0));
                      for (int i = gtid; i < 32 * 1536; i += gthreads) { const int kt = i / 1536, w16 = i - kt * 1536;
                          *(v4u*)(Wb + W_OIN + ((size_t)(40 * 32 + kt) * 256 + 64) * 128 + (size_t)w16 * 16) = (v4u){z0, z0, z0, z0}; } }
                }
            REP_END PH_END
        }
#define xsrc ((fi == 0) ? INF(I_X) : (const float*)X)
#if (PROBE_MASK >> 3) & 1
        PH_BEGIN { constexpr int rep = 0;
            pg8::Gemm g{XN, (const bf16*)(Wb + (which ? W_GU1 : W_GU0)), M_TOK, 2 * D_FF, D_MODEL}; pg8::StaticOrder S; S.init(M_TOK, 2 * D_FF, G, bid);
            pg8::stage_row_scales(lds, SSb, S, tid);
            pg8::EpiSwiGLU E{(bf16*)(R + R_H), D_FF, lds};
            pg8::gemm_phase<pg8::EpiSwiGLU, pg8::StaticOrder, true, true, true, true>(lds, g, S, E, tid);
        } PH_END
#endif
        PH_BEGIN { constexpr int rep = 1; (void)rep;
            pg8::Gemm g{XN, (const bf16*)(Wb + (which ? W_GU1 : W_GU0)), M_TOK, 2 * D_FF, D_MODEL}; pg8::StaticOrder S; S.init(M_TOK, 2 * D_FF, G, bid);
            pg8::stage_row_scales(lds, SSb, S, tid);
            pg8::EpiSwiGLU E{(bf16*)(R + R_H), D_FF, lds};
            pg8::gemm_phase<pg8::EpiSwiGLU, pg8::StaticOrder, true, true, true, true>(lds, g, S, E, tid);
        } PH_END
#if (PROBE_MASK >> 4) & 1
        PH_BEGIN { constexpr int rep = 0;
            pg8::Gemm g{(const bf16*)(R + R_H), (const bf16*)(Wb + (which ? W_D1 : W_D0)), M_TOK, D_MODEL, D_FF}; pg8::MaskOrder S; S.init(M_TOK, D_MODEL, G, bid, 4); S.mask = (PROBE_MASK & 0x20000) ? 7 : 63;
            pg8::EpiResid E{XN, (bf16*)DUMMY, DUMMY + (size_t)M_TOK * D_MODEL, D_MODEL, 1, lds};
            pg8::gemm_phase<pg8::EpiResid, pg8::MaskOrder, true, true, true, true>(lds, g, S, E, tid);
        } PH_END
#endif
        PH_BEGIN { constexpr int rep = 1; (void)rep;
            pg8::Gemm g{(const bf16*)(R + R_H), (const bf16*)(Wb + (which ? W_D1 : W_D0)), M_TOK, D_MODEL, D_FF}; pg8::StaticOrder S; S.init(M_TOK, D_MODEL, G, bid, 4);
            pg8::EpiResid E{XN, rep ? XN : (bf16*)DUMMY, rep ? SSb : DUMMY + (size_t)M_TOK * D_MODEL, D_MODEL, 1, lds};
            pg8::gemm_phase<pg8::EpiResid, pg8::StaticOrder, true, true, true, true>(lds, g, S, E, tid);
        } PH_END
        if (which == 0) {
            const int eo = L >> 1;
            if ((L & 1) == 0) {
#if (PROBE_MASK >> 5) & 1
                PH_BEGIN { constexpr int rep = 0;
                    pg8::Gemm g{XN, (const bf16*)(Wb + W_EIN), M_TOK, EVEN_IN, D_MODEL}; pg8::StaticOrder S; S.init(M_TOK, EVEN_IN, G, bid);
                    pg8::stage_row_scales(lds, SSb, S, tid);
                    pg8::EpiEvenIn E{Qb, Kb, Vb, Ub, ROT, lds};
                    pg8::gemm_phase<pg8::EpiEvenIn, pg8::StaticOrder, true, true, true, true>(lds, g, S, E, tid);
                } PH_END
#endif
                PH_BEGIN { constexpr int rep = 1; (void)rep;
                    pg8::Gemm g{XN, (const bf16*)(Wb + W_EIN), M_TOK, EVEN_IN, D_MODEL}; pg8::StaticOrder S; S.init(M_TOK, EVEN_IN, G, bid);
                    pg8::stage_row_scales(lds, SSb, S, tid);
                    pg8::EpiEvenIn E{Qb, Kb, Vb, Ub, ROT, lds};
                    pg8::gemm_phase<pg8::EpiEvenIn, pg8::StaticOrder, true, true, true, true>(lds, g, S, E, tid);
                } PH_END
                PH_BEGIN
                REP_BEGIN(6)
                    ph_attn_mfma(Qb, Kb, Vb, INF(I_SINK) + eo * A_HEADS, CATb, lds, bid, G, tid);
                REP_END
                REP_BEGIN(10)
                    ph_s5_mfma(PP, eo, Ub, Gb, lds, bid, G, tid);
                REP_END
                PH_END
#if (PROBE_MASK >> 8) & 1
                PH_BEGIN { constexpr int rep = 0;
                    pg8::Gemm g{Gb, (const bf16*)(Wb + W_EGLU), M_TOK, 1024, 1024}; pg8::StaticOrder S; S.init(M_TOK, 1024, G, bid);
                    pg8::EpiGLU E{Gb, INF(I_BGLU) + (size_t)eo * 1024, CATb};
                    pg8::gemm_phase<pg8::EpiGLU, pg8::StaticOrder, true, true, false, true>(lds, g, S, E, tid);
                } PH_END
#endif
                PH_BEGIN { constexpr int rep = 1; (void)rep;
                    pg8::Gemm g{Gb, (const bf16*)(Wb + W_EGLU), M_TOK, 1024, 1024}; pg8::StaticOrder S; S.init(M_TOK, 1024, G, bid);
                    pg8::EpiGLU E{Gb, INF(I_BGLU) + (size_t)eo * 1024, CATb};
                    pg8::gemm_phase<pg8::EpiGLU, pg8::StaticOrder, true, true, false, true>(lds, g, S, E, tid);
                } PH_END
#if (PROBE_MASK >> 8) & 1
                PH_BEGIN { constexpr int rep = 0;
                    pg8::Gemm g{CATb, (const bf16*)(Wb + W_EOUT), M_TOK, D_MODEL, 2048}; pg8::StaticOrder S; S.init(M_TOK, D_MODEL, G, bid, 4);
                    pg8::EpiResid E{XN, rep ? XN : (bf16*)DUMMY, rep ? SSb : DUMMY + (size_t)M_TOK * D_MODEL, D_MODEL, 0, lds};
                    pg8::gemm_phase<pg8::EpiResid, pg8::StaticOrder, true, true, false, true>(lds, g, S, E, tid);
                } PH_END
#endif
                PH_BEGIN { constexpr int rep = 1; (void)rep;
                    pg8::Gemm g{CATb, (const bf16*)(Wb + W_EOUT), M_TOK, D_MODEL, 2048}; pg8::StaticOrder S; S.init(M_TOK, D_MODEL, G, bid, 4);
                    pg8::EpiResid E{XN, rep ? XN : (bf16*)DUMMY, rep ? SSb : DUMMY + (size_t)M_TOK * D_MODEL, D_MODEL, 0, lds};
                    pg8::gemm_phase<pg8::EpiResid, pg8::StaticOrder, true, true, false, true>(lds, g, S, E, tid);
                } PH_END
            } else {
#if (PROBE_MASK >> 5) & 1
                PH_BEGIN { constexpr int rep = 0;
                    pg8::Gemm g{XN, (const bf16*)(Wb + W_OIN), M_TOK, M_IN_PAD, D_MODEL}; pg8::StaticOrder S; S.init(M_TOK, M_IN_PAD, G, bid);
                    pg8::stage_row_scales(lds, SSb, S, tid);
                    pg8::EpiOddIn E{Zb, XBCb, DTb, lds};
                    pg8::gemm_phase<pg8::EpiOddIn, pg8::StaticOrder, true, true, true, true>(lds, g, S, E, tid);
                } PH_END
#endif
                PH_BEGIN { constexpr int rep = 1; (void)rep;
                    ph_dt_mini(XN, (const bf16*)(Wb + W_OIN) + (size_t)40 * 32 * 16384, SSb, DTb, lds, bid, G, tid);
                    pg8::Gemm g{XN, (const bf16*)(Wb + W_OIN), M_TOK, 40 * 256, D_MODEL}; pg8::StaticOrder S; S.init(M_TOK, 40 * 256, G, bid);
                    pg8::stage_row_scales(lds, SSb, S, tid);
                    pg8::EpiOddIn E{Zb, XBCb, DTb, lds};
                    pg8::gemm_phase<pg8::EpiOddIn, pg8::StaticOrder, true, true, true, true>(lds, g, S, E, tid);
                } PH_END
                PH_BEGIN REP_BEGIN(7)
                    ph_conv(rep,XBCb, INF(I_CONVW) + (size_t)eo * 4 * M_CONV_DIM, INF(I_CONVB) + (size_t)eo * M_CONV_DIM, INF(I_DTB) + eo * 64, XBCCb, DTb, gw, NGW, lane, gtid, gthreads);
                REP_END PH_END
                PH_BEGIN REP_BEGIN(9)
#if USE_MFMA_SSD
                    ph_ssd_mfma(XBCCb, DTb, Zb, INF(I_ALOG) + eo * 64, INF(I_MD) + eo * 64, YGb, SSGb, lds, bid, G, tid);
#else
                    ph_ssd_naive(XBCCb, DTb, Zb, INF(I_ALOG) + eo * 64, INF(I_MD) + eo * 64, YGb, SSGb, lds, bid, G, tid);
#endif
                REP_END PH_END
#if (PROBE_MASK >> 8) & 1
                PH_BEGIN { constexpr int rep = 0;
                    pg8::Gemm g{YGb, (const bf16*)(Wb + W_OOUT), M_TOK, D_MODEL, M_INNER}; pg8::StaticOrder S; S.init(M_TOK, D_MODEL, G, bid, 4);
                    pg8::stage_group_scales(lds, SSGb, S, tid);
                    pg8::EpiResid E{XN, rep ? XN : (bf16*)DUMMY, rep ? SSb : DUMMY + (size_t)M_TOK * D_MODEL, D_MODEL, 2, lds};
                    pg8::gemm_phase<pg8::EpiResid, pg8::StaticOrder, true, true, true, true, true>(lds, g, S, E, tid);
                } PH_END
#endif
                PH_BEGIN { constexpr int rep = 1; (void)rep;
                    pg8::Gemm g{YGb, (const bf16*)(Wb + W_OOUT), M_TOK, D_MODEL, M_INNER}; pg8::StaticOrder S; S.init(M_TOK, D_MODEL, G, bid, 4);
                    pg8::stage_group_scales(lds, SSGb, S, tid);
                    pg8::EpiResid E{XN, rep ? XN : (bf16*)DUMMY, rep ? SSb : DUMMY + (size_t)M_TOK * D_MODEL, D_MODEL, 2, lds};
                    pg8::gemm_phase<pg8::EpiResid, pg8::StaticOrder, true, true, true, true, true>(lds, g, S, E, tid);
                } PH_END
            }
        }
    }
#if PROBE_MASK & 0x40000
    for (int e = 0; e < 40; ++e) { PH_BEGIN PH_END }
#endif
    PH_BEGIN REP_BEGIN(2)
        ph_rmsnorm_out(XN, INF(I_FNORM), OUTP, gw, NGW, lane);
    REP_END PH_END
#undef PH_BEGIN
#undef PH_END
}

extern "C" void kernel_launch(void* const* d_in, const int* in_sizes, int n_in, void* d_out, int out_size, void* d_ws, size_t ws_size, hipStream_t stream) {
    static int grid = 0;
    if (grid == 0) {
        if (n_in != 33 || in_sizes[0] != M_TOK * D_MODEL || out_size != M_TOK * D_MODEL || ws_size < WS_END) { fprintf(stderr, "kernel_launch: unexpected shapes (n_in %d, ws %zu < %zu?)\n", n_in, ws_size, (size_t)WS_END); grid = -1; return; }
        int dev = 0, cus = 0;
        if (hipGetDevice(&dev) != hipSuccess || hipDeviceGetAttribute(&cus, hipDeviceAttributeMultiprocessorCount, dev) != hipSuccess) { grid = -1; return; }
        if (hipFuncSetAttribute((const void*)k_fwd, hipFuncAttributeMaxDynamicSharedMemorySize, LDS_BYTES) != hipSuccess) { fprintf(stderr, "kernel_launch: hipFuncSetAttribute failed\n"); grid = -1; return; }
        int per_cu = 0;
        if (hipOccupancyMaxActiveBlocksPerMultiprocessor(&per_cu, (const void*)k_fwd, 512, LDS_BYTES) != hipSuccess || per_cu < 1) fprintf(stderr, "kernel_launch: occupancy query reports %d\n", per_cu);
        (void)hipGetLastError();
        grid = cus;
    }
    if (grid < 0) return;
    (void)hipMemsetAsync((char*)d_ws + WS_CTL, 0, CTL_ZERO_BYTES, stream);
    Params p{};
    for (int i = 0; i < 33; ++i) p.in[i] = d_in[i];
    p.out = (float*)d_out; p.ws = (unsigned char*)d_ws;
#if MK_ONE_LAUNCH
    p.lo = 0; p.hi = NPH;
    hipLaunchKernelGGL(k_fwd, dim3(grid), dim3(512), LDS_BYTES, stream, p);
#else
    for (int ph = 0; ph < NPH; ++ph) { p.lo = ph; p.hi = ph + 1; hipLaunchKernelGGL(k_fwd, dim3(grid), dim3(512), LDS_BYTES, stream, p); }
#endif
}
```

```cpp
#include <hip/hip_runtime.h>
#include <cstdio>
#include <cstdint>

#ifndef MK_ONE_LAUNCH
#define MK_ONE_LAUNCH 1
#endif

#ifndef PROBE_MASK
#define PROBE_MASK 0
#endif
#ifndef USE_MFMA_ATTN
#define USE_MFMA_ATTN 1
#endif
#ifndef USE_MFMA_S5
#define USE_MFMA_S5 1
#endif
#ifndef USE_MFMA_SSD
#define USE_MFMA_SSD 1
#endif

constexpr int D_MODEL = 2048, BATCH = 4, SEQ = 4096, DEPTH = 4, M_TOK = BATCH * SEQ;
constexpr int D_FF = 5632;
constexpr float NORM_EPS = 1e-5f;
constexpr int A_HEADS = 16, A_KV = 4, HD = 64, WINDOW = 128;
constexpr int A_WIDTH = 1024, KV_WIDTH = 256, S5_WIDTH = 1024, S5_GROUP = 16, S5_GROUPS = 64, S5_STATE = 64;
constexpr int EVEN_IN = 2560;
constexpr int M_INNER = 4096, M_HEADS = 64, M_GROUPS = 8, M_STATE = 128, M_CONV_DIM = 6144, M_IN = 10304, M_IN_PAD = 10496;

namespace pg8 {
#define PG8_LAS __attribute__((address_space(3)))
typedef unsigned short bf16_t;
typedef short bf16x8 __attribute__((ext_vector_type(8)));
typedef float f32x4 __attribute__((ext_vector_type(4)));
typedef unsigned u32x4 __attribute__((ext_vector_type(4)));
constexpr int BM = 256, BK = 64, HALF = 128, HTB = HALF * BK * 2  , STAGE_BYTES = 8 * HTB, NXCD = 8, WGM = 8;

__host__ __device__ __forceinline__ int lds_byte(int r, int c) { const int st = (r >> 4) * 2 + (c >> 5), rr = r & 15, cc = c & 31, ob = rr * 64 + cc * 2; return st * 1024 + (ob ^ (((ob >> 9) & 1) << 5)); }
__host__ __device__ __forceinline__ void stage_rc(int b, int& R, int& C) { const int st = b / 1024, sb = b % 1024, swz = sb ^ (((sb >> 9) & 1) << 5); R = (st >> 1) * 16 + swz / 64; C = (st & 1) * 32 + (swz % 64) / 2; }
__host__ __device__ __forceinline__ int perm32(int rho) { const int n = rho >> 4, i = rho & 15; return 8 * (i >> 2) + 4 * n + (i & 3); }

struct Unit { int pm, pn, ui; };
struct Gemm { const bf16_t* A; const bf16_t* Bt; int M, N, K; };

struct StaticOrder {
    int nM, nN, nwg, G, c, wgm;
    __host__ __device__ void init(int M, int N, int G_, int c_, int wgm_ = WGM) { nM = M / BM; nN = N / BM; nwg = nM * nN; G = G_; c = c_; wgm = wgm_; }
    __host__ __device__ bool next(int i, Unit& u) const {
        const long L = (long)i * G + c; if (L >= nwg) return false;
        int wgid = (int)L; { const int q = nwg / NXCD, r = nwg % NXCD, xcd = wgid % NXCD, off = wgid / NXCD; wgid = (xcd < r ? xcd * (q + 1) : r * (q + 1) + (xcd - r) * q) + off; }
        const int nig = wgm * nN, gid = wgid / nig, fm = gid * wgm, gsz = (nM - fm) < wgm ? (nM - fm) : wgm;
        u.pm = fm + ((wgid % nig) % gsz); u.pn = (wgid % nig) / gsz; return true;
    }
    __device__ __forceinline__ void a_ready(const Unit&) const {}
    __device__ __forceinline__ void done(const Unit&) const {}
};

struct MaskOrder : StaticOrder { int mask; __host__ __device__ bool next(int i, Unit& u) const { const bool ok = StaticOrder::next(i, u); u.pm &= mask; return ok; } };
__device__ __forceinline__ unsigned cvt_pk_bf16(float lo, float hi) { unsigned r; asm volatile("v_cvt_pk_bf16_f32 %0, %1, %2" : "=v"(r) : "v"(lo), "v"(hi)); return r; }
__device__ __forceinline__ void store16_sc1(void* p, u32x4 v) { asm volatile("global_store_dwordx4 %0, %1, off sc1\n\ts_nop 1" :: "v"(p), "v"(v) : "memory"); }
__device__ __forceinline__ float bf_lo(unsigned w) { return __uint_as_float(w << 16); }
__device__ __forceinline__ float bf_hi(unsigned w) { return __uint_as_float(w & 0xffff0000u); }
__device__ __forceinline__ float fast_sigmoid(float x) { return __builtin_amdgcn_rcpf(1.0f + __expf(-x)); }
__device__ __forceinline__ f32x4 shfl_xor4(f32x4 v, int mask) { f32x4 r; r[0] = __shfl_xor(v[0], mask); r[1] = __shfl_xor(v[1], mask); r[2] = __shfl_xor(v[2], mask); r[3] = __shfl_xor(v[3], mask); return r; }

constexpr int GS_LDS_OFF = 131072;
constexpr int RS_LDS_OFF = 131072;
template <class Sched> __device__ __forceinline__ void stage_row_scales(PG8_LAS unsigned char* lds, const float* SS, const Sched& S, int tid) {
    PG8_LAS float* sl = (PG8_LAS float*)(lds + RS_LDS_OFF);
    Unit u;
    int prev_pm = -1; float val = 0.f;
    for (int i = 0; i < 12 && S.next(i, u); ++i) {
        if (tid < 256) {
            if (u.pm != prev_pm) { const f32x4* p = (const f32x4*)(SS + (size_t)(u.pm * BM + tid) * 32); float t = 0.f;
#pragma unroll
                for (int k = 0; k < 8; ++k) { const f32x4 a = p[k]; t += (a[0] + a[1]) + (a[2] + a[3]); }
                val = __builtin_amdgcn_rsqf(t * (1.0f / 2048.0f) + 1e-5f); }
            sl[i * 256 + tid] = val; }
        prev_pm = u.pm;
    }
    __syncthreads();
}
template <class Sched> __device__ __forceinline__ void stage_group_scales(PG8_LAS unsigned char* lds, const float* SSG, const Sched& S, int tid) {
    PG8_LAS float* gt = (PG8_LAS float*)(lds + GS_LDS_OFF);
    Unit u;
    for (int i = 0; i < 4 && S.next(i, u); ++i) {
        if (tid < 256) { const f32x4* p = (const f32x4*)(SSG + (size_t)(u.pm * BM + tid) * 64); float s[8]; f32x4 q[16];
#pragma unroll
            for (int g = 0; g < 16; ++g) q[g] = p[g];
            __builtin_amdgcn_sched_barrier(0);
#pragma unroll
            for (int g = 0; g < 8; ++g) { const f32x4 a = q[2 * g], c = q[2 * g + 1]; s[g] = __builtin_amdgcn_rsqf((((a[0] + a[1]) + (a[2] + a[3])) + ((c[0] + c[1]) + (c[2] + c[3]))) * (1.0f / 512.0f) + 1e-5f); }
#pragma unroll
            for (int g = 0; g < 7; ++g) gt[(i * 256 + tid) * 8 + g] = s[g] * __builtin_amdgcn_rcpf(s[g + 1]);
            gt[(i * 256 + tid) * 8 + 7] = s[7]; }
    }
    __syncthreads();
}
__device__ __forceinline__ void row_scales(PG8_LAS unsigned char* lds, const Unit& u, int wr, int fr, float (&s)[8]) {
    const PG8_LAS float* sl = (const PG8_LAS float*)(lds + RS_LDS_OFF) + u.ui * 256 + wr * 64 + fr;
#pragma unroll
    for (int i = 0; i < 8; ++i) s[i] = sl[(i >> 2) * HALF + (i & 3) * 16];
}


struct EpiSwiGLU {
    static constexpr bool PERM = true, AFTER_DRAIN = false;
    bf16_t* H; int ldc; PG8_LAS unsigned char* lds;
    __device__ __forceinline__ void operator()(const f32x4 (&acc)[2][2][4][2], const Unit& u, int wr, int wc, int fr, int fq) const {
        float rs[8]; row_scales(lds, u, wr, fr, rs);
#pragma unroll
        for (int ai = 0; ai < 2; ++ai)
#pragma unroll
            for (int m = 0; m < 4; ++m) {
                bf16_t* rowp = H + ((size_t)(u.pm * (ldc >> 6) + u.pn * 2 + (wc >> 1)) * BM + (wr * 64 + fr + ai * HALF + m * 16)) * 64 + (wc & 1) * 32 + 8 * fq;
                const float sc = rs[ai * 4 + m], sc2 = sc * sc, scl = -1.4426950408889634f * sc;
                typedef float f2 __attribute__((ext_vector_type(2)));
                const float isc = __builtin_amdgcn_rcpf(sc2); const f2 scl2 = {scl, scl}, isc2 = {isc, isc};
                f2 e[4], gu[4]; float h[8];
#pragma unroll
                for (int n = 0; n < 2; ++n)
#pragma unroll
                    for (int jp = 0; jp < 2; ++jp) { const f2 g = {acc[ai][0][m][n][2 * jp], acc[ai][0][m][n][2 * jp + 1]}, uu = {acc[ai][1][m][n][2 * jp], acc[ai][1][m][n][2 * jp + 1]};
                        const f2 t = g * scl2; e[2 * n + jp] = (f2){__builtin_amdgcn_exp2f(t.x), __builtin_amdgcn_exp2f(t.y)}; gu[2 * n + jp] = g * uu; }
#pragma unroll
                for (int k = 0; k < 4; ++k) { const f2 d = __builtin_elementwise_fma(e[k], isc2, isc2); e[k] = (f2){__builtin_amdgcn_rcpf(d.x), __builtin_amdgcn_rcpf(d.y)}; }
#pragma unroll
                for (int k = 0; k < 4; ++k) { const f2 hh = gu[k] * e[k]; h[2 * k] = hh.x; h[2 * k + 1] = hh.y; }
                u32x4 w; w.x = cvt_pk_bf16(h[0], h[1]); w.y = cvt_pk_bf16(h[2], h[3]); w.z = cvt_pk_bf16(h[4], h[5]); w.w = cvt_pk_bf16(h[6], h[7]);
                *(u32x4*)rowp = w; }
    }
};
struct EpiResid {
    static constexpr bool PERM = true, AFTER_DRAIN = false;
    const bf16_t* res; bf16_t* out; float* SS; int ldc; int half;
    PG8_LAS unsigned char* lds;
    __device__ __forceinline__ void load_half(u32x4 (&r)[4][2], int ai, const bf16_t* rb) const {
#pragma unroll
        for (int m = 0; m < 4; ++m)
#pragma unroll
            for (int bj = 0; bj < 2; ++bj) r[m][bj] = *(const u32x4*)(rb + bj * 32768 + ai * 8192 + m * 1024);
    }
    __device__ __forceinline__ void store_half(const u32x4 (&r)[4][2], const f32x4 (&acc)[2][2][4][2], int ai, bf16_t* ob, int row0, int pn, int wc, int fq, float scale, int uui) const {
#pragma unroll
        for (int m = 0; m < 4; ++m) { const int row = row0 + ai * HALF + m * 16; float q = 0.f;
            if (half == 2) scale = ((const PG8_LAS float*)(lds + GS_LDS_OFF))[(size_t)((uui * 256 + (row & 255)) * 8 + 7)];
#pragma unroll
            for (int bj = 0; bj < 2; ++bj) { const u32x4 w0 = r[m][bj]; const f32x4 a0 = acc[ai][bj][m][0], a1 = acc[ai][bj][m][1];
                const float x0 = bf_lo(w0.x) + a0[0] * scale, x1 = bf_hi(w0.x) + a0[1] * scale, x2 = bf_lo(w0.y) + a0[2] * scale, x3 = bf_hi(w0.y) + a0[3] * scale;
                const float x4 = bf_lo(w0.z) + a1[0] * scale, x5 = bf_hi(w0.z) + a1[1] * scale, x6 = bf_lo(w0.w) + a1[2] * scale, x7 = bf_hi(w0.w) + a1[3] * scale;
                u32x4 w; w.x = cvt_pk_bf16(x0, x1); w.y = cvt_pk_bf16(x2, x3); w.z = cvt_pk_bf16(x4, x5); w.w = cvt_pk_bf16(x6, x7);
                *(u32x4*)(ob + bj * 32768 + ai * 8192 + m * 1024) = w;
                q += ((x0 * x0 + x1 * x1) + (x2 * x2 + x3 * x3)) + ((x4 * x4 + x5 * x5) + (x6 * x6 + x7 * x7)); }
            q += __shfl_xor(q, 16); q += __shfl_xor(q, 32);
            if (fq == 0) SS[(size_t)row * 32 + pn * 4 + wc] = q; }
    }
    __device__ __forceinline__ void operator()(const f32x4 (&acc)[2][2][4][2], const Unit& u, int wr, int wc, int fr, int fq) const {
        const int row0 = u.pm * BM + wr * 64 + fr; const float scale = half ? 0.5f : 1.0f;
        const size_t base = ((size_t)(u.pm * (ldc >> 6) + u.pn * 4 + (wc >> 1)) * BM + (wr * 64 + fr)) * 64 + (wc & 1) * 32 + 8 * fq;
        u32x4 ra[4][2], rb[4][2];
        load_half(ra, 0, res + base); load_half(rb, 1, res + base);
        store_half(ra, acc, 0, out + base, row0, u.pn, wc, fq, scale, u.ui);
        store_half(rb, acc, 1, out + base, row0, u.pn, wc, fq, scale, u.ui);
    }
};
struct EpiEvenIn {
    static constexpr bool PERM = true, AFTER_DRAIN = false;
    bf16_t *Q, *K, *V, *U; const float* rot; PG8_LAS unsigned char* lds;
    __device__ __forceinline__ void operator()(const f32x4 (&acc)[2][2][4][2], const Unit& u, int wr, int wc, int fr, int fq) const {
        const int pn = u.pn; bf16_t* dst; int ldc, colt; bool rotary = false; float sc = 1.f;
        if (pn < 4) { dst = Q; ldc = 1024; colt = pn * 256; rotary = true; sc = 0.125f; }
        else if (pn == 4) { dst = K; ldc = 256; colt = 0; rotary = true; }
        else if (pn == 5) { dst = V; ldc = 256; colt = 0; }
        else { dst = U; ldc = 1024; colt = (pn - 6) * 256; }
        const int row0 = u.pm * BM + wr * 64 + fr, col0 = colt + wc * 32 + 8 * fq;
        const bool rotw = rotary && ((wc & 1) == 0);
        float rs[8]; row_scales(lds, u, wr, fr, rs);
#pragma unroll
        for (int aim = 0; aim < 4; ++aim) { const int ai = aim >> 1;
            f32x4 cs[4][4];
            if (rotw) {
#pragma unroll
                for (int m = 2 * (aim & 1); m < 2 * (aim & 1) + 2; ++m) { const f32x4* rp = (const f32x4*)(rot + (size_t)(row0 + ai * HALF + m * 16) * 16); cs[m][0] = rp[0]; cs[m][1] = rp[1]; cs[m][2] = rp[2]; cs[m][3] = rp[3]; }
            }
#pragma unroll
            for (int m = 2 * (aim & 1); m < 2 * (aim & 1) + 2; ++m) { const int row = row0 + ai * HALF + m * 16; bf16_t* rowp = dst + (size_t)row * ldc + col0;
#pragma unroll
                for (int bj = 0; bj < 2; ++bj) { f32x4 v0 = acc[ai][bj][m][0] * rs[ai * 4 + m], v1 = acc[ai][bj][m][1] * rs[ai * 4 + m];
                    if (rotw) { const f32x4 p0 = shfl_xor4(v0, 16), p1 = shfl_xor4(v1, 16);
                        if (fq == 0) { v0 = v0 * cs[m][0] - p0 * cs[m][2]; v1 = v1 * cs[m][1] - p1 * cs[m][3]; }
                        else if (fq == 1) { v0 = v0 * cs[m][0] + p0 * cs[m][2]; v1 = v1 * cs[m][1] + p1 * cs[m][3]; } }
                    v0 = v0 * sc; v1 = v1 * sc;
                    u32x4 w; w.x = cvt_pk_bf16(v0[0], v0[1]); w.y = cvt_pk_bf16(v0[2], v0[3]); w.z = cvt_pk_bf16(v1[0], v1[1]); w.w = cvt_pk_bf16(v1[2], v1[3]);
                    *(u32x4*)(rowp + bj * HALF) = w; } }
        }
    }
};
struct EpiGLU {
    static constexpr bool PERM = true, AFTER_DRAIN = false;
    const bf16_t* G; const float* bias; bf16_t* CAT;
    __device__ __forceinline__ void operator()(const f32x4 (&acc)[2][2][4][2], const Unit& u, int wr, int wc, int fr, int fq) const {
        const int row0 = u.pm * BM + wr * 64 + fr, col0 = u.pn * BM + wc * 32 + 8 * fq;
        f32x4 bv[2][2];
#pragma unroll
        for (int bj = 0; bj < 2; ++bj) { bv[bj][0] = *(const f32x4*)(bias + col0 + bj * HALF); bv[bj][1] = *(const f32x4*)(bias + col0 + bj * HALF + 4); }
#pragma unroll
        for (int ai = 0; ai < 2; ++ai) {
            u32x4 gw[4][2];
#pragma unroll
            for (int m = 0; m < 4; ++m)
#pragma unroll
                for (int bj = 0; bj < 2; ++bj) gw[m][bj] = *(const u32x4*)(G + (size_t)(row0 + ai * HALF + m * 16) * 1024 + col0 + bj * HALF);
#pragma unroll
            for (int m = 0; m < 4; ++m) { const int row = row0 + ai * HALF + m * 16;
#pragma unroll
                for (int bj = 0; bj < 2; ++bj) { const int col = col0 + bj * HALF; const u32x4 g4 = gw[m][bj];
                    const f32x4 a0 = acc[ai][bj][m][0] + bv[bj][0], a1 = acc[ai][bj][m][1] + bv[bj][1];
                    float o[8];
                    o[0] = bf_lo(g4.x) * fast_sigmoid(a0[0]); o[1] = bf_hi(g4.x) * fast_sigmoid(a0[1]); o[2] = bf_lo(g4.y) * fast_sigmoid(a0[2]); o[3] = bf_hi(g4.y) * fast_sigmoid(a0[3]);
                    o[4] = bf_lo(g4.z) * fast_sigmoid(a1[0]); o[5] = bf_hi(g4.z) * fast_sigmoid(a1[1]); o[6] = bf_lo(g4.w) * fast_sigmoid(a1[2]); o[7] = bf_hi(g4.w) * fast_sigmoid(a1[3]);
                    u32x4 w; w.x = cvt_pk_bf16(o[0], o[1]); w.y = cvt_pk_bf16(o[2], o[3]); w.z = cvt_pk_bf16(o[4], o[5]); w.w = cvt_pk_bf16(o[6], o[7]);
                    *(u32x4*)(CAT + (size_t)row * 2048 + 1024 + col) = w; } }
        }
    }
};
struct EpiOddIn {
    static constexpr bool PERM = true, AFTER_DRAIN = false;
    bf16_t *Z, *XBC; float* DT; PG8_LAS unsigned char* lds;
    __device__ __forceinline__ void operator()(const f32x4 (&acc)[2][2][4][2], const Unit& u, int wr, int wc, int fr, int fq) const {
        const int pn = u.pn; const int row0 = u.pm * BM + wr * 64 + fr;
        float rs[8]; row_scales(lds, u, wr, fr, rs);
        if (pn == 40) {
            if (wc < 2) {
#pragma unroll
                for (int ai = 0; ai < 2; ++ai)
#pragma unroll
                    for (int m = 0; m < 4; ++m) { float* rowp = DT + (size_t)(row0 + ai * HALF + m * 16) * 64 + wc * 32 + 8 * fq;
                        *(f32x4*)rowp = acc[ai][0][m][0] * rs[ai * 4 + m]; *(f32x4*)(rowp + 4) = acc[ai][0][m][1] * rs[ai * 4 + m]; }
            }
            return;
        }
        bf16_t* dst; int ldc, colt;
        if (pn < 16) { dst = Z; ldc = 4096; colt = pn * 256; } else { dst = XBC; ldc = 6144; colt = (pn - 16) * 256; }
        const int col0 = colt + wc * 32 + 8 * fq;
#pragma unroll
        for (int ai = 0; ai < 2; ++ai)
#pragma unroll
            for (int m = 0; m < 4; ++m) { bf16_t* rowp = dst + (size_t)(row0 + ai * HALF + m * 16) * ldc + col0;
#pragma unroll
                for (int bj = 0; bj < 2; ++bj) { const f32x4 v0 = acc[ai][bj][m][0] * rs[ai * 4 + m], v1 = acc[ai][bj][m][1] * rs[ai * 4 + m];
                    u32x4 w; w.x = cvt_pk_bf16(v0[0], v0[1]); w.y = cvt_pk_bf16(v0[2], v0[3]); w.z = cvt_pk_bf16(v1[0], v1[1]); w.w = cvt_pk_bf16(v1[2], v1[3]);
                    *(u32x4*)(rowp + bj * HALF) = w; } }
    }
};

template <class Epi, class Sched, bool ALIGN_EPI = false, bool SP2 = false, bool TILED_A = false, bool TILED_B = false, bool GSCALE = false>
__device__ __forceinline__ void gemm_phase(PG8_LAS unsigned char* lds, const Gemm g, const Sched& S, const Epi& E, int tid_in) {
    int tid = tid_in; const int wid = __builtin_amdgcn_readfirstlane(tid >> 6), lane = tid & 63, wr = wid >> 2, wc = wid & 3, fr = lane & 15, fq = lane >> 4;
    const int K = g.K, nt = K / BK;
    unsigned voffA[2], voffB[2];
#pragma unroll
    for (int i = 0; i < 2; ++i) { int R, C; stage_rc(tid * 16 + i * 8192, R, C); const int Rb = Epi::PERM ? ((R & ~31) + perm32(R & 31)) : R;
        voffA[i] = (unsigned)(R * (TILED_A ? BK : K) + C) * 2u; voffB[i] = (unsigned)(Rb * (TILED_B ? BK : K) + C) * 2u; }
    const size_t kstepA = TILED_A ? (size_t)(BM * BK * 2) : (size_t)(BK * 2), kstepB = TILED_B ? (size_t)(BM * BK * 2) : (size_t)(BK * 2);
    const size_t hstepA = TILED_A ? (size_t)(HALF * BK * 2) : (size_t)HALF * K * 2, hstepB = TILED_B ? (size_t)(HALF * BK * 2) : (size_t)HALF * K * 2;
    const size_t tstepA = TILED_A ? (size_t)nt * (BM * BK * 2) : 2 * hstepA, tstepB = TILED_B ? (size_t)nt * (BM * BK * 2) : 2 * hstepB;
    const unsigned ldsw = (unsigned)wid * 1024u;
    const int aoff = lds_byte(wr * 64 + fr, fq * 8), boff = lds_byte(wc * 32 + fr, fq * 8);
#define PG8_SA(b, h) (((b) * 2 + (h)) * HTB)
#define PG8_SB(b, h) ((4 + (b) * 2 + (h)) * HTB)
#define PG8_STAGE(bufoff, gbase, voff) do { _Pragma("unroll") for (int _i = 0; _i < 2; ++_i) \
        __builtin_amdgcn_global_load_lds((const unsigned*)((const char*)(gbase) + (voff)[_i]), (PG8_LAS unsigned*)(lds + (bufoff) + ldsw + _i * 8192), 16, 0, 0); } while (0)
#define PG8_LDA(dst, b, h) do { _Pragma("unroll") for (int m = 0; m < 4; ++m) _Pragma("unroll") for (int k = 0; k < 2; ++k) dst[m][k] = *(const PG8_LAS bf16x8*)(lds + PG8_SA(b, h) + aoff + m * 2048 + k * 1024); } while (0)
#define PG8_LDB(dst, b, h) do { _Pragma("unroll") for (int n = 0; n < 2; ++n) _Pragma("unroll") for (int k = 0; k < 2; ++k) dst[n][k] = *(const PG8_LAS bf16x8*)(lds + PG8_SB(b, h) + boff + n * 2048 + k * 1024); } while (0)
#define PG8_MMA(ai, bj, At, Bt) do { __builtin_amdgcn_s_setprio(1); _Pragma("unroll") for (int m = 0; m < 4; ++m) _Pragma("unroll") for (int n = 0; n < 2; ++n) _Pragma("unroll") for (int k = 0; k < 2; ++k) \
        acc[ai][bj][m][n] = __builtin_amdgcn_mfma_f32_16x16x32_bf16(Bt[n][k], At[m][k], acc[ai][bj][m][n], 0, 0, 0); __builtin_amdgcn_s_setprio(0); } while (0)
#define PG8_WAIT_V(n) asm volatile("s_waitcnt vmcnt(" #n ")" ::: "memory")
#define PG8_WAIT_L(n) asm volatile("s_waitcnt lgkmcnt(" #n ")" ::: "memory")
#define PG8_BAR __builtin_amdgcn_s_barrier()
#define PG8_SCHED __builtin_amdgcn_sched_barrier(0)
    Unit cur, nxt; int ui = 0;
    if (!S.next(0, cur)) return;
    cur.ui = 0;
    f32x4 acc[2][2][4][2];
    typedef unsigned long pg8_u64x2 __attribute__((ext_vector_type(2)));
#define PG8_ZERO_ACC() do { unsigned long z64 = 0ul; asm volatile("" : "+v"(z64));     \
        _Pragma("unroll") for (int a = 0; a < 2; ++a) _Pragma("unroll") for (int b = 0; b < 2; ++b) _Pragma("unroll") for (int m = 0; m < 4; ++m) _Pragma("unroll") for (int n = 0; n < 2; ++n) \
            acc[a][b][m][n] = __builtin_bit_cast(f32x4, (pg8_u64x2){z64, z64}); } while (0)
    PG8_ZERO_ACC();
    bf16x8 At[4][2], B0[2][2], B1[2][2];
    const char* cA = (const char*)g.A + (size_t)cur.pm * tstepA; const char* cB = (const char*)g.Bt + (size_t)cur.pn * tstepB;
    S.a_ready(cur);
    if constexpr (SP2) {
        PG8_STAGE(PG8_SB(0, 0), cB, voffB); PG8_STAGE(PG8_SB(0, 1), cB + hstepB, voffB); PG8_STAGE(PG8_SA(0, 0), cA, voffA); PG8_STAGE(PG8_SA(0, 1), cA + hstepA, voffA);
        if (wr == 1) PG8_BAR;
        PG8_WAIT_V(2); PG8_BAR;
        PG8_STAGE(PG8_SB(1, 0), cB + kstepB, voffB); PG8_STAGE(PG8_SA(1, 0), cA + kstepA, voffA); PG8_STAGE(PG8_SB(1, 1), cB + hstepB + kstepB, voffB);
        PG8_WAIT_V(6); PG8_BAR;
    } else {
        PG8_STAGE(PG8_SB(0, 0), cB, voffB); PG8_STAGE(PG8_SA(0, 0), cA, voffA); PG8_STAGE(PG8_SB(0, 1), cB + hstepB, voffB); PG8_STAGE(PG8_SA(0, 1), cA + hstepA, voffA);
        if (wr == 1) PG8_BAR;
        PG8_WAIT_V(4); PG8_BAR;
        PG8_STAGE(PG8_SB(1, 0), cB + kstepB, voffB); PG8_STAGE(PG8_SA(1, 0), cA + kstepA, voffA); PG8_STAGE(PG8_SB(1, 1), cB + hstepB + kstepB, voffB);
        PG8_WAIT_V(6); PG8_BAR;
    }
    for (;;) {
        const bool has_next = S.next(ui + 1, nxt); nxt.ui = ui + 1;
        const char* nA = has_next ? (const char*)g.A + (size_t)nxt.pm * tstepA : cA; const char* nB = has_next ? (const char*)g.Bt + (size_t)nxt.pn * tstepB : cB;
        for (int t = 0; t < nt; t += 2) {
            const bool last = (t == nt - 2);
            const char* a1 = cA + (size_t)(t + 1) * kstepA;
            const char* a2 = last ? nA : cA + (size_t)(t + 2) * kstepA; const char* b2 = last ? nB : cB + (size_t)(t + 2) * kstepB;
            const char* a3 = a2 + kstepA; const char* b3 = b2 + kstepB;
            if (last && has_next) S.a_ready(nxt);
            if constexpr (GSCALE) { int tq = t; asm volatile("" : "+s"(tq));
              if (tq > 0 && (tq & 7) == 0) {
                const PG8_LAS float* gt = (const PG8_LAS float*)(lds + GS_LDS_OFF) + (size_t)((cur.ui * 256 + wr * 64 + fr) * 8 + (tq >> 3) - 1);
#pragma unroll
                for (int a = 0; a < 2; ++a)
#pragma unroll
                    for (int m = 0; m < 4; ++m) { const float rr = gt[(a * HALF + m * 16) * 8];
#pragma unroll
                        for (int bq = 0; bq < 2; ++bq)
#pragma unroll
                            for (int n = 0; n < 2; ++n) acc[a][bq][m][n] = acc[a][bq][m][n] * rr; }
                PG8_SCHED; } }
            if constexpr (SP2) {
            PG8_LDB(B0, 0, 0); PG8_LDB(B1, 0, 1); PG8_SCHED; PG8_LDA(At, 0, 0); PG8_STAGE(PG8_SA(1, 1), a1 + hstepA, voffA);
            PG8_WAIT_V(8); PG8_WAIT_L(0); PG8_BAR; PG8_MMA(0, 0, At, B0); PG8_MMA(0, 1, At, B1); PG8_BAR; PG8_SCHED;
            PG8_LDA(At, 0, 1); PG8_STAGE(PG8_SB(0, 0), b2, voffB); PG8_STAGE(PG8_SB(0, 1), b2 + hstepB, voffB); PG8_STAGE(PG8_SA(0, 0), a2, voffA);
            PG8_WAIT_V(8); PG8_WAIT_L(0); PG8_BAR; PG8_MMA(1, 0, At, B0); PG8_MMA(1, 1, At, B1); PG8_BAR; PG8_SCHED;
            PG8_LDB(B0, 1, 0); PG8_LDB(B1, 1, 1); PG8_SCHED; PG8_LDA(At, 1, 0); PG8_STAGE(PG8_SA(0, 1), a2 + hstepA, voffA);
            PG8_WAIT_V(8); PG8_WAIT_L(0); PG8_BAR; PG8_MMA(0, 0, At, B0); PG8_MMA(0, 1, At, B1); PG8_BAR; PG8_SCHED;
            PG8_LDA(At, 1, 1); PG8_STAGE(PG8_SB(1, 0), b3, voffB); PG8_STAGE(PG8_SB(1, 1), b3 + hstepB, voffB); PG8_STAGE(PG8_SA(1, 0), a3, voffA);
            PG8_WAIT_V(8); PG8_WAIT_L(0); PG8_BAR; PG8_MMA(1, 0, At, B0); PG8_MMA(1, 1, At, B1); PG8_BAR; PG8_SCHED;
            } else {
            PG8_LDB(B0, 0, 0); PG8_SCHED; PG8_LDA(At, 0, 0); PG8_STAGE(PG8_SA(1, 1), a1 + hstepA, voffA);
            PG8_WAIT_L(8); PG8_BAR; PG8_WAIT_L(0); PG8_MMA(0, 0, At, B0); PG8_BAR; PG8_SCHED;
            PG8_LDB(B1, 0, 1); PG8_STAGE(PG8_SB(0, 0), b2, voffB);
            PG8_BAR; PG8_WAIT_L(0); PG8_MMA(0, 1, At, B1); PG8_BAR;
            PG8_LDA(At, 0, 1); PG8_STAGE(PG8_SA(0, 0), a2, voffA);
            PG8_BAR; PG8_WAIT_L(0); PG8_MMA(1, 0, At, B0); PG8_BAR; PG8_SCHED;
            PG8_STAGE(PG8_SB(0, 1), b2 + hstepB, voffB);
            PG8_WAIT_V(6); PG8_BAR; PG8_MMA(1, 1, At, B1); PG8_BAR;
            PG8_LDB(B0, 1, 0); PG8_SCHED; PG8_LDA(At, 1, 0); PG8_STAGE(PG8_SA(0, 1), a2 + hstepA, voffA);
            PG8_WAIT_L(8); PG8_BAR; PG8_WAIT_L(0); PG8_MMA(0, 0, At, B0); PG8_BAR; PG8_SCHED;
            PG8_LDB(B1, 1, 1); PG8_STAGE(PG8_SB(1, 0), b3, voffB);
            PG8_BAR; PG8_WAIT_L(0); PG8_MMA(0, 1, At, B1); PG8_BAR;
            PG8_LDA(At, 1, 1); PG8_STAGE(PG8_SA(1, 0), a3, voffA);
            PG8_BAR; PG8_WAIT_L(0); PG8_MMA(1, 0, At, B0); PG8_BAR; PG8_SCHED;
            PG8_STAGE(PG8_SB(1, 1), b3 + hstepB, voffB);
            PG8_WAIT_V(6); PG8_BAR; PG8_MMA(1, 1, At, B1); PG8_BAR;
            }
        }
        if constexpr (ALIGN_EPI) { if (wr == 0) PG8_BAR; }
        if constexpr (!Epi::AFTER_DRAIN) { int fr_e = fr, fq_e = fq; asm volatile("" : "+v"(fr_e), "+v"(fq_e));
            E(acc, cur, wr, wc, fr_e, fq_e); S.done(cur); }
        if (!has_next) break;
        PG8_ZERO_ACC();
        cur = nxt; cA = nA; cB = nB; ++ui;
        if constexpr (ALIGN_EPI) { if (wr == 1) PG8_BAR; }
    }
    PG8_WAIT_V(0);
    if constexpr (!ALIGN_EPI) { if (wr == 0) PG8_BAR; }
    PG8_BAR;
    if constexpr (Epi::AFTER_DRAIN) { E.fused(acc, cur, wr, wc, fr, fq, lds, wid, lane); S.done(cur); }
#undef PG8_SA
#undef PG8_SB
#undef PG8_STAGE
#undef PG8_LDA
#undef PG8_LDB
#undef PG8_MMA
#undef PG8_ZERO_ACC
#undef PG8_WAIT_V
#undef PG8_WAIT_L
#undef PG8_BAR
#undef PG8_SCHED
}
}

#define GAS __attribute__((address_space(1)))
#define LAS __attribute__((address_space(3)))
#define CAS __attribute__((address_space(4)))
typedef unsigned short bf16;
typedef unsigned v4u __attribute__((ext_vector_type(4)));
typedef unsigned v2u __attribute__((ext_vector_type(2)));
typedef float f32x4 __attribute__((ext_vector_type(4)));
typedef float f32x2v __attribute__((ext_vector_type(2)));
typedef __bf16 bf16x2v __attribute__((ext_vector_type(2)));
__device__ __forceinline__ unsigned pkbf(float a, float b) { const f32x2v v = {a, b}; const bf16x2v r = __builtin_convertvector(v, bf16x2v); return __builtin_bit_cast(unsigned, r); }
#define LDS_WAIT() asm volatile("s_waitcnt lgkmcnt(0)" ::: "memory")
#define LDS_BARRIER() do { asm volatile("s_waitcnt lgkmcnt(0)" ::: "memory"); __builtin_amdgcn_s_barrier(); asm volatile("" ::: "memory"); } while (0)
__device__ __forceinline__ unsigned f2bf(float f) { unsigned u = __builtin_bit_cast(unsigned, f); return (u + 0x7fffu + ((u >> 16) & 1u)) >> 16; }
__device__ __forceinline__ unsigned pk2(float lo, float hi) { return f2bf(lo) | (f2bf(hi) << 16); }
__device__ __forceinline__ float bf2f(unsigned short b) { return __uint_as_float(((unsigned)b) << 16); }
__device__ __forceinline__ float blo(unsigned w) { return __uint_as_float(w << 16); }
__device__ __forceinline__ float bhi(unsigned w) { return __uint_as_float(w & 0xffff0000u); }
__device__ __forceinline__ float wave_sum(float v) {
#pragma unroll
    for (int o = 1; o < 64; o <<= 1) v += __shfl_xor(v, o);
    return v;
}
__device__ __forceinline__ float wave_max(float v) {
#pragma unroll
    for (int o = 1; o < 64; o <<= 1) v = fmaxf(v, __shfl_xor(v, o));
    return v;
}
__device__ __forceinline__ float sigmoidf_(float x) { return __builtin_amdgcn_rcpf(1.0f + __expf(-x)); }
__device__ __forceinline__ float fsig(float x) { return __builtin_amdgcn_rcpf(1.0f + __expf(-x)); }
__device__ __forceinline__ float siluf_(float x) { return x * sigmoidf_(x); }
__device__ __forceinline__ float gelu_tanh(float x) { const float z = 0.7978845608028654f * (x + 0.044715f * x * x * x); const float t = 1.0f - 2.0f * __builtin_amdgcn_rcpf(__expf(2.0f * z) + 1.0f); return 0.5f * x * (1.0f + t); }
__device__ __forceinline__ float softplusf_(float x) { const float e = __expf(x); return x > 20.f ? x : (e < 1e-3f ? e * (1.0f - 0.5f * e) : __logf(1.0f + e)); }

#define XB_TMO      128
#define XB_XCNT(j)  (256  + 64 * (j))
#define XB_XSUB(j)  (1280 + 64 * (j))
#define XB_XGEN(j)  (2304 + 64 * (j))
#define XB_TOP      3328
#define XB_TOPGEN   3392
#define XCD_BAR_WORDS 3456
#define XB_SPIN_CAP (1u << 18)

__device__ __forceinline__ unsigned xb_ld(unsigned* p)              { return __hip_atomic_load(p, __ATOMIC_RELAXED, __HIP_MEMORY_SCOPE_AGENT); }
__device__ __forceinline__ unsigned xb_add(unsigned* p, unsigned v) { return __hip_atomic_fetch_add(p, v, __ATOMIC_RELAXED, __HIP_MEMORY_SCOPE_AGENT); }
__device__ __forceinline__ unsigned xb_xcc_id() { return (unsigned)__builtin_amdgcn_s_getreg((3 << 11) | 20) & 0xFu; }
#define XB_SPIN(cond, bar) do { unsigned _sp = 0; while (cond) { __builtin_amdgcn_s_sleep(1); \
    if ((++_sp & 255u) == 0u) { if (xb_ld(&(bar)[XB_TMO])) break; if (_sp > XB_SPIN_CAP) { atomicAdd(&(bar)[XB_TMO], 1u); break; } } } } while (0)

struct XcdBarrier {
    unsigned* bar; unsigned x;
    volatile LAS unsigned* st; bool lead;
};

__device__ __forceinline__ XcdBarrier xcd_barrier_post(unsigned* bar, volatile LAS unsigned* st) {
    XcdBarrier b; b.bar = bar; b.x = xb_xcc_id(); b.st = st;
    if (threadIdx.x == 0) (void)xb_add(&bar[XB_XCNT(b.x)], 1u);
    return b;
}
__device__ __forceinline__ void xcd_barrier_complete(unsigned* bar, unsigned x, unsigned& nloc, unsigned& nx) {
    const unsigned G = gridDim.x * gridDim.y * gridDim.z;
    unsigned sum, cnt, mine, sp = 0u;
    for (;;) {
        sum = 0u; cnt = 0u; mine = 0u;
#pragma unroll
        for (unsigned j = 0; j < 16; ++j) { const unsigned c = xb_ld(&bar[XB_XCNT(j)]); sum += c; cnt += (c > 0u) ? 1u : 0u; mine = (j == x) ? c : mine; }
        if (sum == G) break;
        __builtin_amdgcn_s_sleep(1);
        if ((++sp & 255u) == 0u) { if (xb_ld(&bar[XB_TMO])) break; if (sp > XB_SPIN_CAP) { atomicAdd(&bar[XB_TMO], 1u); break; } }
    }
    nloc = mine > 0u ? mine : 1u; nx = cnt > 0u ? cnt : 1u;
}

__device__ __forceinline__ void xcd_barrier(const XcdBarrier& b) {
    asm volatile("s_waitcnt vmcnt(0)" ::: "memory");
    __syncthreads();
    if (b.lead) {
        unsigned* bar = b.bar;
        __builtin_amdgcn_s_waitcnt(0);
        unsigned nloc = b.st[0], nx = b.st[1];
        if (nloc == 0u) { xcd_barrier_complete(bar, b.x, nloc, nx); b.st[0] = nloc; b.st[1] = nx; }
        const unsigned old = xb_add(&bar[XB_XSUB(b.x)], 1u);
        const unsigned gen = old / nloc;
        if (old + 1u == (gen + 1u) * nloc) {
            __builtin_amdgcn_fence(__ATOMIC_RELEASE, "agent");
            asm volatile("s_waitcnt vmcnt(0)" ::: "memory");
            const unsigned og = xb_add(&bar[XB_TOP], 1u);
            const unsigned tg = og / nx;
            if (og + 1u == (tg + 1u) * nx) xb_add(&bar[XB_TOPGEN], 1u);
            else XB_SPIN(xb_ld(&bar[XB_TOPGEN]) == tg, bar);
            __builtin_amdgcn_fence(__ATOMIC_ACQUIRE, "agent");
            xb_add(&bar[XB_XGEN(b.x)], 1u);
            asm volatile("s_waitcnt vmcnt(0)" ::: "memory");
        } else {
            XB_SPIN(xb_ld(&bar[XB_XGEN(b.x)]) == gen, bar);
            __builtin_amdgcn_fence(__ATOMIC_ACQUIRE, "agent");
            asm volatile("s_waitcnt vmcnt(0)" ::: "memory");
        }
    }
    __syncthreads();
}

constexpr size_t MiB = 1u << 20;
constexpr size_t WS_CTL = 0, CTL_ZERO_BYTES = 64 * 1024;
constexpr size_t WS_ROT = 1 * MiB;
constexpr size_t WS_X = 2 * MiB;
constexpr size_t WS_XN = 130 * MiB;
constexpr size_t WS_R = 194 * MiB;
constexpr size_t R_H = 0;
constexpr size_t R_Q = 0, R_K = 32 * MiB, R_V = 40 * MiB, R_U = 48 * MiB, R_G = 80 * MiB, R_CAT = 112 * MiB;
constexpr size_t R_Z = 0, R_XBC = 128 * MiB, R_XBCC = 320 * MiB, R_DT = 512 * MiB, R_YG = 128 * MiB, R_YN = 0;
constexpr size_t WS_W = 710 * MiB;
constexpr size_t W_GU0 = 0, W_D0 = 44 * MiB, W_GU1 = 66 * MiB, W_D1 = 110 * MiB, W_MIX = 132 * MiB;
constexpr size_t W_EIN = W_MIX, W_EGLU = W_MIX + 10 * MiB, W_EOUT = W_MIX + 12 * MiB;
constexpr size_t W_OIN = W_MIX, W_OOUT = W_MIX + 41 * MiB;
constexpr size_t WS_SS = 899 * MiB;
constexpr size_t WS_SSG = 901 * MiB;
constexpr size_t WS_END = 905 * MiB;
constexpr int CW_BAR = 1024;
static_assert((CW_BAR + XCD_BAR_WORDS) * 4 <= (int)CTL_ZERO_BYTES, "barrier words inside the memset region");

constexpr int RING_BYTES = 131072;
constexpr int MISC_OFF = 163840 - 64;
constexpr int LDS_BYTES = 163840;

struct Params { const void* in[33]; float* out; unsigned char* ws; int lo, hi; };

enum { I_X = 0, I_POS, I_NFFN1, I_F1G, I_F1U, I_F1D, I_NMIX, I_NFFN2, I_F2G, I_F2U, I_F2D, I_EWIN, I_SINK, I_ARE, I_AIM, I_LOGDT, I_BRE, I_BIM, I_CRE, I_CIM, I_S5D, I_WGLU, I_BGLU, I_EWOUT,
       I_MWIN, I_CONVW, I_CONVB, I_DTB, I_ALOG, I_MD, I_MNORM, I_MWOUT, I_FNORM };

__device__ __forceinline__ void convert_matrix(const float* W, int K, int N, bf16* WT, int grp, int gstride, int off, LAS float* scr, int gw, int NGW, int lane) {
    const int nblk = N / 32, nitems = (K / 64) * nblk;
    for (int item = gw; item < nitems; item += NGW) {
        const int kb = item / nblk, nb = item % nblk, k0 = 64 * kb, n0 = 32 * nb;
#pragma unroll 8
        for (int i = 0; i < 32; ++i) { const int kk = 2 * i + (lane >> 5); scr[kk * 33 + (lane & 31)] = W[(size_t)(k0 + kk) * N + n0 + (lane & 31)]; }
        LDS_WAIT(); asm volatile("" ::: "memory");
        const int c = lane & 7;
#pragma unroll
        for (int j = 0; j < 4; ++j) { const int n = (lane >> 3) + 8 * j; const LAS float* s = scr + (8 * c) * 33 + n;
            v4u o; o.x = pk2(s[0 * 33], s[1 * 33]); o.y = pk2(s[2 * 33], s[3 * 33]); o.z = pk2(s[4 * 33], s[5 * 33]); o.w = pk2(s[6 * 33], s[7 * 33]);
            const int nn = n0 + n; const int row = (nn / grp) * gstride + (nn % grp) + off;
            *(v4u*)(WT + (size_t)row * K + k0 + 8 * c) = o; }
        LDS_WAIT(); asm volatile("" ::: "memory");
    }
}
__device__ __forceinline__ void ph_rmsnorm_bf16(const float* src, const float* g, bf16* dst, int gw, int NGW, int lane) {
    for (int m = gw; m < M_TOK; m += NGW) {
        const f32x4* xr = (const f32x4*)(src + (size_t)m * D_MODEL) + lane;
        f32x4 v[8]; float s = 0.f;
#pragma unroll
        for (int j = 0; j < 8; ++j) { v[j] = xr[64 * j]; s += (v[j].x * v[j].x + v[j].y * v[j].y) + (v[j].z * v[j].z + v[j].w * v[j].w); }
        const float r = 1.0f / sqrtf(wave_sum(s) * (1.0f / D_MODEL) + NORM_EPS);
        v2u* o8 = (v2u*)(dst + (size_t)m * D_MODEL) + lane;
#pragma unroll
        for (int j = 0; j < 8; ++j) { const f32x4 gg = ((const f32x4*)g)[lane + 64 * j]; v2u w; w.x = pk2(v[j].x * r * gg.x, v[j].y * r * gg.y); w.y = pk2(v[j].z * r * gg.z, v[j].w * r * gg.w); o8[64 * j] = w; }
    }
}
__device__ __forceinline__ size_t xb_off(int row, int col) { return ((size_t)((row >> 8) * (D_MODEL / 64) + (col >> 6)) * 256 + (row & 255)) * 64 + (col & 63); }
__device__ __forceinline__ void ph_xb_ss(const float* src, bf16* dst, float* SS, int gw, int NGW, int lane) {
    for (int m = gw; m < M_TOK; m += NGW) {
        const f32x4* xr = (const f32x4*)(src + (size_t)m * D_MODEL) + lane;
        f32x4 v[8]; float s = 0.f;
#pragma unroll
        for (int j = 0; j < 8; ++j) { v[j] = xr[64 * j]; s += (v[j].x * v[j].x + v[j].y * v[j].y) + (v[j].z * v[j].z + v[j].w * v[j].w); }
        s = wave_sum(s);
#pragma unroll
        for (int j = 0; j < 8; ++j) { v2u w; w.x = pk2(v[j].x, v[j].y); w.y = pk2(v[j].z, v[j].w); *(v2u*)(dst + xb_off(m, 4 * (lane + 64 * j))) = w; }
        if (lane < 32) SS[(size_t)m * 32 + lane] = (lane == 0) ? s : 0.f;
    }
}
__device__ __forceinline__ void ph_rmsnorm_out(const bf16* src, const float* g, float* dst, int gw, int NGW, int lane) {
    for (int m = gw; m < M_TOK; m += NGW) {
        float v[4][8]; float s = 0.f;
#pragma unroll
        for (int j = 0; j < 4; ++j) { const v4u w = *(const v4u*)(src + xb_off(m, 8 * (lane + 64 * j))); v[j][0] = blo(w.x); v[j][1] = bhi(w.x); v[j][2] = blo(w.y); v[j][3] = bhi(w.y); v[j][4] = blo(w.z); v[j][5] = bhi(w.z); v[j][6] = blo(w.w); v[j][7] = bhi(w.w);
#pragma unroll
            for (int k = 0; k < 8; ++k) s += v[j][k] * v[j][k]; }
        const float r = 1.0f / sqrtf(wave_sum(s) * (1.0f / D_MODEL) + NORM_EPS);
#pragma unroll
        for (int j = 0; j < 4; ++j) { const int c0 = 8 * (lane + 64 * j); const f32x4 g0 = *(const f32x4*)(g + c0), g1 = *(const f32x4*)(g + c0 + 4);
            f32x4 o0, o1; o0.x = v[j][0] * r * g0.x; o0.y = v[j][1] * r * g0.y; o0.z = v[j][2] * r * g0.z; o0.w = v[j][3] * r * g0.w; o1.x = v[j][4] * r * g1.x; o1.y = v[j][5] * r * g1.y; o1.z = v[j][6] * r * g1.z; o1.w = v[j][7] * r * g1.w;
            *(f32x4*)(dst + (size_t)m * D_MODEL + c0) = o0; *(f32x4*)(dst + (size_t)m * D_MODEL + c0 + 4) = o1; }
    }
}
__device__ __forceinline__ void ph_rmsnorm_f32(const float* src, const float* g, float* dst, int gw, int NGW, int lane) {
    for (int m = gw; m < M_TOK; m += NGW) {
        const f32x4* xr = (const f32x4*)(src + (size_t)m * D_MODEL) + lane;
        f32x4 v[8]; float s = 0.f;
#pragma unroll
        for (int j = 0; j < 8; ++j) { v[j] = xr[64 * j]; s += (v[j].x * v[j].x + v[j].y * v[j].y) + (v[j].z * v[j].z + v[j].w * v[j].w); }
        const float r = 1.0f / sqrtf(wave_sum(s) * (1.0f / D_MODEL) + NORM_EPS);
        f32x4* o = (f32x4*)(dst + (size_t)m * D_MODEL) + lane;
#pragma unroll
        for (int j = 0; j < 8; ++j) { const f32x4 gg = ((const f32x4*)g)[lane + 64 * j]; o[64 * j] = v[j] * r * gg; }
    }
}
__device__ __forceinline__ void ph_attn_naive(const bf16* Q, const bf16* K, const bf16* V, const float* sinks, bf16* CAT, int gw, int NGW, int lane) {
    for (int it = gw; it < M_TOK * A_HEADS; it += NGW) {
        const int m = it >> 4, h = it & 15, kvh = h >> 2, b = m >> 12, s = m & (SEQ - 1);
        int k0 = s - (WINDOW - 1); if (k0 < 0) k0 = 0; const int nk = s - k0 + 1;
        float q[64];
        { const v4u* qp = (const v4u*)(Q + (size_t)m * A_WIDTH + h * HD);
#pragma unroll
          for (int c = 0; c < 8; ++c) { const v4u w = qp[c]; q[8 * c + 0] = blo(w.x); q[8 * c + 1] = bhi(w.x); q[8 * c + 2] = blo(w.y); q[8 * c + 3] = bhi(w.y); q[8 * c + 4] = blo(w.z); q[8 * c + 5] = bhi(w.z); q[8 * c + 6] = blo(w.w); q[8 * c + 7] = bhi(w.w); } }
        float sc[2];
#pragma unroll
        for (int r = 0; r < 2; ++r) { const int j = lane + 64 * r; float d = -1e30f;
            if (j < nk) { const v4u* kp = (const v4u*)(K + (size_t)(b * SEQ + k0 + j) * KV_WIDTH + kvh * HD); d = 0.f;
#pragma unroll
                for (int c = 0; c < 8; ++c) { const v4u w = kp[c]; d += q[8 * c + 0] * blo(w.x) + q[8 * c + 1] * bhi(w.x) + q[8 * c + 2] * blo(w.y) + q[8 * c + 3] * bhi(w.y) + q[8 * c + 4] * blo(w.z) + q[8 * c + 5] * bhi(w.z) + q[8 * c + 6] * blo(w.w) + q[8 * c + 7] * bhi(w.w); } }
            sc[r] = d; }
        const float sk = sinks[h];
        const float mx = fmaxf(wave_max(fmaxf(sc[0], sc[1])), sk);
        const float e0 = (lane < nk) ? __expf(sc[0] - mx) : 0.f, e1 = (lane + 64 < nk) ? __expf(sc[1] - mx) : 0.f;
        const float den = wave_sum(e0 + e1) + __expf(sk - mx);
        const float inv = 1.0f / den, p0 = e0 * inv, p1 = e1 * inv;
        float o = 0.f; const bf16* vp = V + (size_t)(b * SEQ + k0) * KV_WIDTH + kvh * HD + lane;
        for (int j = 0; j < nk; ++j) { const float pj = (j < 64) ? __shfl(p0, j) : __shfl(p1, j - 64); o += pj * bf2f(vp[(size_t)j * KV_WIDTH]); }
        CAT[(size_t)m * 2048 + h * HD + lane] = (bf16)f2bf(o);
    }
}
__device__ __forceinline__ void ph_s5_naive(const CAS Params* PP, int e, const bf16* U, bf16* G, LAS unsigned char* lds, int bid, int nblk, int tid_in) {
    LAS float* hbuf = (LAS float*)lds;
    LAS float* ubuf = hbuf + 64 * 132;
    LAS float* cbuf = ubuf + 64 * 16;
    int tid = tid_in; const int lane = tid & 63, wave = __builtin_amdgcn_readfirstlane(tid >> 6);
    const float* a_re = ((const float*)(const GAS float*)PP->in[I_ARE]) + (size_t)e * 64 * 64; const float* a_im = ((const float*)(const GAS float*)PP->in[I_AIM]) + (size_t)e * 64 * 64;
    const float* log_dt = ((const float*)(const GAS float*)PP->in[I_LOGDT]) + (size_t)e * 64;
    const float* b_re = ((const float*)(const GAS float*)PP->in[I_BRE]) + (size_t)e * 64 * 64 * 16; const float* b_im = ((const float*)(const GAS float*)PP->in[I_BIM]) + (size_t)e * 64 * 64 * 16;
    const float* c_re = ((const float*)(const GAS float*)PP->in[I_CRE]) + (size_t)e * 64 * 16 * 64; const float* c_im = ((const float*)(const GAS float*)PP->in[I_CIM]) + (size_t)e * 64 * 16 * 64;
    const float* d_skip = ((const float*)(const GAS float*)PP->in[I_S5D]) + (size_t)e * 1024;
    for (int unit = bid; unit < BATCH * S5_GROUPS; unit += nblk) {
        const int b = unit >> 6, g = unit & 63;
        __syncthreads();
        for (int i = tid; i < 2048; i += 512) { const int c = i >> 7, k = i & 127; cbuf[c * 132 + k] = (k < 64) ? c_re[(size_t)(g * 16 + c) * 64 + k] : -c_im[(size_t)(g * 16 + c) * 64 + (k - 64)]; }
        float abr = 0.f, abi = 0.f, bbr[16], bbi[16], hr = 0.f, hi = 0.f;
#pragma unroll
        for (int c = 0; c < 16; ++c) { bbr[c] = 0.f; bbi[c] = 0.f; }
        if (wave == 0) {
            const int p = lane; const float dt = expf(log_dt[g]); const float ar = a_re[g * 64 + p], ai = a_im[g * 64 + p];
            const float mag = expf(ar * dt); abr = mag * cosf(ai * dt); abi = mag * sinf(ai * dt);
            const float nr = abr - 1.0f, ni = abi, den = ar * ar + ai * ai; const float cr = (nr * ar + ni * ai) / den, ci = (ni * ar - nr * ai) / den;
#pragma unroll
            for (int c = 0; c < 16; ++c) { const float br = b_re[(size_t)(g * 64 + p) * 16 + c], bi = b_im[(size_t)(g * 64 + p) * 16 + c]; bbr[c] = cr * br - ci * bi; bbi[c] = cr * bi + ci * br; }
        }
        for (int chunk = 0; chunk < SEQ / 64; ++chunk) {
            const int m0 = b * SEQ + chunk * 64;
            for (int i = tid; i < 1024; i += 512) { const int t = i >> 4, c = i & 15; ubuf[i] = bf2f(U[(size_t)(m0 + t) * S5_WIDTH + g * 16 + c]); }
            __syncthreads();
            if (wave == 0) {
                for (int t = 0; t < 64; ++t) {
                    const LAS f32x4* up = (const LAS f32x4*)(ubuf + t * 16); float bur = 0.f, bui = 0.f;
#pragma unroll
                    for (int c4 = 0; c4 < 4; ++c4) { const f32x4 u4 = up[c4];
#pragma unroll
                        for (int j = 0; j < 4; ++j) { bur += bbr[4 * c4 + j] * u4[j]; bui += bbi[4 * c4 + j] * u4[j]; } }
                    const float nhr = abr * hr - abi * hi + bur, nhi = abr * hi + abi * hr + bui; hr = nhr; hi = nhi;
                    hbuf[t * 132 + lane] = hr; hbuf[t * 132 + 64 + lane] = hi;
                }
            }
            __syncthreads();
            { const int t = tid >> 3, c0 = 2 * (tid & 7); float y0 = 0.f, y1 = 0.f;
              const LAS f32x4* hp = (const LAS f32x4*)(hbuf + t * 132); const LAS f32x4* ca = (const LAS f32x4*)(cbuf + c0 * 132); const LAS f32x4* cb = (const LAS f32x4*)(cbuf + (c0 + 1) * 132);
#pragma unroll 8
              for (int k4 = 0; k4 < 32; ++k4) { const f32x4 h4 = hp[k4], a4 = ca[k4], b4 = cb[k4]; y0 += (h4.x * a4.x + h4.y * a4.y) + (h4.z * a4.z + h4.w * a4.w); y1 += (h4.x * b4.x + h4.y * b4.y) + (h4.z * b4.z + h4.w * b4.w); }
              y0 += d_skip[g * 16 + c0] * ubuf[t * 16 + c0]; y1 += d_skip[g * 16 + c0 + 1] * ubuf[t * 16 + c0 + 1];
              *(unsigned*)(G + (size_t)(m0 + t) * S5_WIDTH + g * 16 + c0) = pk2(gelu_tanh(y0), gelu_tanh(y1)); }
            __syncthreads();
        }
    }
}
__device__ __forceinline__ void ph_conv(int do_dt, const bf16* XBC, const float* cw, const float* cb, const float* dt_bias, bf16* XBCC, float* DT, int gw, int NGW, int lane, int gtid, int gthreads) {
    constexpr int RUN = 32, NCB = M_CONV_DIM / 512, NRUN = M_TOK / RUN;
    for (int it = gw; it < NCB * NRUN; it += NGW) {
        const int cbk = it % NCB, run = it / NCB, c8 = cbk * 512 + lane * 8, m0 = run * RUN, s0 = m0 & (SEQ - 1);
        float w[4][8], bias[8];
#pragma unroll
        for (int tap = 0; tap < 4; ++tap) { const f32x4 a = *(const f32x4*)(cw + (size_t)tap * M_CONV_DIM + c8), b = *(const f32x4*)(cw + (size_t)tap * M_CONV_DIM + c8 + 4);
            w[tap][0] = a.x; w[tap][1] = a.y; w[tap][2] = a.z; w[tap][3] = a.w; w[tap][4] = b.x; w[tap][5] = b.y; w[tap][6] = b.z; w[tap][7] = b.w; }
        { const f32x4 a = *(const f32x4*)(cb + c8), b = *(const f32x4*)(cb + c8 + 4); bias[0] = a.x; bias[1] = a.y; bias[2] = a.z; bias[3] = a.w; bias[4] = b.x; bias[5] = b.y; bias[6] = b.z; bias[7] = b.w; }
        v4u h0, h1, h2;
        { unsigned z0 = 0u; asm volatile("" : "+v"(z0)); const v4u z = (v4u){z0, z0, z0, z0};
          const bf16* p = XBC + (size_t)m0 * M_CONV_DIM + c8;
          h0 = (s0 >= 3) ? *(const v4u*)(p - 3 * (size_t)M_CONV_DIM) : z; h1 = (s0 >= 2) ? *(const v4u*)(p - 2 * (size_t)M_CONV_DIM) : z; h2 = (s0 >= 1) ? *(const v4u*)(p - (size_t)M_CONV_DIM) : z; }
        v4u ina[8], inb[8];
#define CONV_LOAD(dst, T0) _Pragma("unroll") for (int t = 0; t < 8; ++t) dst[t] = *(const v4u*)(XBC + (size_t)(m0 + (T0) + t) * M_CONV_DIM + c8)
#define CONV_TAP(tap, v) acc[0] += w[tap][0] * blo(v.x); acc[1] += w[tap][1] * bhi(v.x); acc[2] += w[tap][2] * blo(v.y); acc[3] += w[tap][3] * bhi(v.y); \
                         acc[4] += w[tap][4] * blo(v.z); acc[5] += w[tap][5] * bhi(v.z); acc[6] += w[tap][6] * blo(v.w); acc[7] += w[tap][7] * bhi(v.w);
#define CONV_BATCH(src, T0) _Pragma("unroll") for (int t = 0; t < 8; ++t) { const v4u cur = src[t]; float acc[8]; \
                _Pragma("unroll") for (int j = 0; j < 8; ++j) acc[j] = bias[j]; \
                CONV_TAP(0, h0) CONV_TAP(1, h1) CONV_TAP(2, h2) CONV_TAP(3, cur) \
                v4u o; o.x = pkbf(acc[0] * fsig(acc[0]), acc[1] * fsig(acc[1])); o.y = pkbf(acc[2] * fsig(acc[2]), acc[3] * fsig(acc[3])); \
                o.z = pkbf(acc[4] * fsig(acc[4]), acc[5] * fsig(acc[5])); o.w = pkbf(acc[6] * fsig(acc[6]), acc[7] * fsig(acc[7])); \
                *(v4u*)(XBCC + (size_t)(m0 + (T0) + t) * M_CONV_DIM + c8) = o; \
                h0 = h1; h1 = h2; h2 = cur; }
        CONV_LOAD(ina, 0);
#pragma unroll 1
        for (int t0 = 0; t0 < RUN; t0 += 16) {
            CONV_LOAD(inb, t0 + 8); __builtin_amdgcn_sched_barrier(0);
            CONV_BATCH(ina, t0)
            if (t0 + 16 < RUN) { CONV_LOAD(ina, t0 + 16); } __builtin_amdgcn_sched_barrier(0);
            CONV_BATCH(inb, t0 + 8)
        }
#undef CONV_LOAD
#undef CONV_TAP
#undef CONV_BATCH
    }
    if (do_dt) for (int i = gtid; i < M_TOK * M_HEADS; i += gthreads) DT[i] = softplusf_(DT[i] + dt_bias[i & 63]);
}
__device__ __forceinline__ void ph_ssd_naive(const bf16* XBCC, const float* DT, const bf16* Z, const float* a_log, const float* d_skip, bf16* YG, LAS unsigned char* lds, int bid, int nblk, int tid_in) {
    LAS float* xs = (LAS float*)lds;
    LAS float* Bs = xs + 32 * 64;
    LAS float* Cs = Bs + 32 * 128;
    LAS float* ys = Cs + 32 * 128;
    LAS float* dts = ys + 32 * 64;
    LAS float* das = dts + 32;
    int tid = tid_in; const int p = tid >> 3, nb = tid & 7;
    for (int unit = bid; unit < BATCH * M_HEADS; unit += nblk) {
        const int b = unit >> 6, h = unit & 63, grp = h >> 3; const float a = -expf(a_log[h]), Dh = d_skip[h];
        float S[16];
#pragma unroll
        for (int i = 0; i < 16; ++i) S[i] = 0.f;
        for (int chunk = 0; chunk < SEQ / 32; ++chunk) {
            const int m0 = b * SEQ + chunk * 32;
            { const int t = (tid * 4) >> 6, pp = (tid * 4) & 63; const v2u w = *(const v2u*)(XBCC + (size_t)(m0 + t) * M_CONV_DIM + h * 64 + pp);
              *(LAS f32x4*)(xs + t * 64 + pp) = (f32x4){blo(w.x), bhi(w.x), blo(w.y), bhi(w.y)}; }
            { const int t = (tid * 8) >> 7, n = (tid * 8) & 127;
              const v4u wb = *(const v4u*)(XBCC + (size_t)(m0 + t) * M_CONV_DIM + 4096 + grp * 128 + n), wc = *(const v4u*)(XBCC + (size_t)(m0 + t) * M_CONV_DIM + 5120 + grp * 128 + n);
              *(LAS f32x4*)(Bs + t * 128 + n) = (f32x4){blo(wb.x), bhi(wb.x), blo(wb.y), bhi(wb.y)}; *(LAS f32x4*)(Bs + t * 128 + n + 4) = (f32x4){blo(wb.z), bhi(wb.z), blo(wb.w), bhi(wb.w)};
              *(LAS f32x4*)(Cs + t * 128 + n) = (f32x4){blo(wc.x), bhi(wc.x), blo(wc.y), bhi(wc.y)}; *(LAS f32x4*)(Cs + t * 128 + n + 4) = (f32x4){blo(wc.z), bhi(wc.z), blo(wc.w), bhi(wc.w)}; }
            if (tid < 32) { const float dt = DT[(size_t)(m0 + tid) * 64 + h]; dts[tid] = dt; das[tid] = __expf(a * dt); }
            __syncthreads();
            for (int t = 0; t < 32; ++t) {
                const float dA = das[t], xv = xs[t * 64 + p], xdt = xv * dts[t]; float acc = 0.f;
#pragma unroll
                for (int i4 = 0; i4 < 4; ++i4) { const f32x4 B4 = *(const LAS f32x4*)(Bs + t * 128 + nb * 16 + 4 * i4), C4 = *(const LAS f32x4*)(Cs + t * 128 + nb * 16 + 4 * i4);
#pragma unroll
                    for (int j = 0; j < 4; ++j) { S[4 * i4 + j] = S[4 * i4 + j] * dA + xdt * B4[j]; acc += C4[j] * S[4 * i4 + j]; } }
                acc += __shfl_xor(acc, 1); acc += __shfl_xor(acc, 2); acc += __shfl_xor(acc, 4);
                if (nb == 0) ys[t * 64 + p] = acc + Dh * xv;
            }
            __syncthreads();
            { const int t = (tid * 4) >> 6, pp = (tid * 4) & 63; const f32x4 y4 = *(const LAS f32x4*)(ys + t * 64 + pp);
              const v2u zw = *(const v2u*)(Z + (size_t)(m0 + t) * M_INNER + h * 64 + pp);
              v2u o; o.x = pk2(y4.x * siluf_(blo(zw.x)), y4.y * siluf_(bhi(zw.x))); o.y = pk2(y4.z * siluf_(blo(zw.y)), y4.w * siluf_(bhi(zw.y)));
              *(v2u*)(YG + (size_t)(m0 + t) * M_INNER + h * 64 + pp) = o; }
        }
        __syncthreads();
    }
}
__device__ __forceinline__ void ph_gnorm(const bf16* YG, const float* ng, bf16* YN, int gw, int NGW, int lane) {
    for (int m = gw; m < M_TOK; m += NGW) {
#pragma unroll 2
        for (int g8 = 0; g8 < 8; ++g8) {
            const v4u w = *(const v4u*)(YG + (size_t)m * M_INNER + g8 * 512 + lane * 8);
            float v[8] = {blo(w.x), bhi(w.x), blo(w.y), bhi(w.y), blo(w.z), bhi(w.z), blo(w.w), bhi(w.w)};
            float s = 0.f;
#pragma unroll
            for (int j = 0; j < 8; ++j) s += v[j] * v[j];
            const float r = 1.0f / sqrtf(wave_sum(s) * (1.0f / 512.0f) + NORM_EPS);
            const f32x4 g0 = *(const f32x4*)(ng + g8 * 512 + lane * 8), g1 = *(const f32x4*)(ng + g8 * 512 + lane * 8 + 4);
            v4u o; o.x = pk2(v[0] * r * g0.x, v[1] * r * g0.y); o.y = pk2(v[2] * r * g0.z, v[3] * r * g0.w); o.z = pk2(v[4] * r * g1.x, v[5] * r * g1.y); o.w = pk2(v[6] * r * g1.z, v[7] * r * g1.w);
            *(v4u*)(YN + (size_t)m * M_INNER + g8 * 512 + lane * 8) = o;
        }
    }
}


typedef short bf16x8v __attribute__((ext_vector_type(8)));
typedef short s16x4v __attribute__((ext_vector_type(4)));
typedef float f32x16 __attribute__((ext_vector_type(16)));
#define MFMA32(a, b, c) __builtin_amdgcn_mfma_f32_32x32x16_bf16((a), (b), (c), 0, 0, 0)
__device__ __forceinline__ int crow(int reg, int h) { return (reg & 3) + 8 * (reg >> 2) + 4 * h; }
__device__ __forceinline__ bf16x8v pack8(const f32x16& x, int s) {
    v4u p; p.x = pkbf(x[8 * s + 0], x[8 * s + 1]); p.y = pkbf(x[8 * s + 2], x[8 * s + 3]); p.z = pkbf(x[8 * s + 4], x[8 * s + 5]); p.w = pkbf(x[8 * s + 6], x[8 * s + 7]);
    return __builtin_bit_cast(bf16x8v, p);
}
__device__ __forceinline__ bf16x8v tr_frag(const LAS bf16* base, int stride, int rowA, int rowB, int ctile, int lane) {
    const int i16 = lane & 15, q = i16 >> 2, pp = i16 & 3, c0 = ctile + 16 * ((lane >> 4) & 1) + 4 * pp;
    const s16x4v lo = __builtin_amdgcn_ds_read_tr16_b64_v4i16((LAS s16x4v*)(base + (rowA + q) * stride + c0));
    const s16x4v hi = __builtin_amdgcn_ds_read_tr16_b64_v4i16((LAS s16x4v*)(base + (rowB + q) * stride + c0));
    return __builtin_shufflevector(lo, hi, 0, 1, 2, 3, 4, 5, 6, 7);
}
__device__ __forceinline__ bf16x8v row_frag(const LAS bf16* base, int stride, int row, int k0) { return *(const LAS bf16x8v*)(base + row * stride + k0); }

__device__ __forceinline__ void ph_attn_mfma(const bf16* Q, const bf16* K, const bf16* V, const float* sinks, bf16* CAT, LAS unsigned char* lds, int bid, int nblk, int tid_in) {
    constexpr int KS = 72;
    LAS bf16* Ks = (LAS bf16*)lds; LAS bf16* Vs = Ks + 256 * KS;
    int tid = tid_in;
    const int lane = tid & 63, wave = __builtin_amdgcn_readfirstlane(tid >> 6), r = lane & 31, h = lane >> 5;
    for (int unit = bid; unit < BATCH * (SEQ / 128) * A_KV; unit += nblk) {
        const int b = unit >> 7, blk = (unit & 127) >> 2, kvh = unit & 3;
        const int m0 = b * SEQ + blk * 128;
        LDS_BARRIER();
        const int g = wave & 3, qh = wave >> 2, head = kvh * 4 + g;
        bf16x8v Qf[4], Qn[4];
#pragma unroll
        for (int kk = 0; kk < 4; ++kk) Qf[kk] = *(const bf16x8v*)(Q + (size_t)(m0 + qh * 64 + r) * A_WIDTH + head * HD + 16 * kk + 8 * h);
#pragma unroll
        for (int i = 0; i < 4; ++i) { const int c = tid + 512 * i, row = c >> 3, c8 = (c & 7) * 8;
            unsigned z0 = 0u; asm volatile("" : "+v"(z0));
            v4u kv = (v4u){z0, z0, z0, z0}, vv = kv;
            if (blk > 0 || row >= 128) { const size_t go = (size_t)(m0 - 128 + row) * KV_WIDTH + kvh * HD + c8; kv = *(const v4u*)(K + go); vv = *(const v4u*)(V + go); }
            *(LAS v4u*)(Ks + row * KS + c8) = kv; *(LAS v4u*)(Vs + row * KS + c8) = vv; }
        LDS_BARRIER();
        const float sink = sinks[head];
#pragma unroll 1
        for (int qt = 0; qt < 2; ++qt) {
            const int i0 = qh * 64 + qt * 32, kt0 = i0 >> 5, iq = i0 + r;
            if (qt == 0) {
#pragma unroll
                for (int kk = 0; kk < 4; ++kk) Qn[kk] = *(const bf16x8v*)(Q + (size_t)(m0 + qh * 64 + 32 + r) * A_WIDTH + head * HD + 16 * kk + 8 * h); }
            f32x16 S[5];
#pragma unroll
            for (int t = 0; t < 5; ++t) {
#pragma unroll
                for (int i = 0; i < 16; ++i) S[t][i] = 0.f;
#pragma unroll
                for (int kk = 0; kk < 4; ++kk) S[t] = MFMA32(row_frag(Ks, KS, 32 * (kt0 + t) + r, 16 * kk + 8 * h), Qf[kk], S[t]);
            }
            float mx = -1e30f;
#pragma unroll
            for (int t = 0; t < 5; ++t) {
                const bool tile_out = (blk == 0) && (32 * (kt0 + t) < 128);
#pragma unroll
                for (int i = 0; i < 16; ++i) { const int j = 32 * (kt0 + t) + crow(i, h);
                    const bool valid = (t == 0) ? (j >= iq + 1) : ((t == 4) ? (j <= iq + 128) : true);
                    const float s = (valid && !tile_out) ? S[t][i] : -1e30f; S[t][i] = s; mx = fmaxf(mx, s); } }
            mx = fmaxf(mx, __shfl_xor(mx, 32)); mx = fmaxf(mx, sink);
            float sum = 0.f;
#pragma unroll
            for (int t = 0; t < 5; ++t)
#pragma unroll
                for (int i = 0; i < 16; ++i) { const float p = __expf(S[t][i] - mx); S[t][i] = p; sum += p; }
            sum += __shfl_xor(sum, 32); sum += __expf(sink - mx);
            const float inv = 1.0f / sum;
            f32x16 O[2];
#pragma unroll
            for (int i = 0; i < 16; ++i) { O[0][i] = 0.f; O[1][i] = 0.f; }
#pragma unroll
            for (int t = 0; t < 5; ++t) {
#pragma unroll
                for (int i = 0; i < 16; ++i) S[t][i] *= inv;
#pragma unroll
                for (int sp = 0; sp < 2; ++sp) { const bf16x8v Af = pack8(S[t], sp); const int rowA = 32 * (kt0 + t) + 16 * sp + 4 * h;
#pragma unroll
                    for (int dt = 0; dt < 2; ++dt) O[dt] = MFMA32(Af, tr_frag(Vs, KS, rowA, rowA + 8, 32 * dt, lane), O[dt]); }
            }
#pragma unroll
            for (int dt = 0; dt < 2; ++dt)
#pragma unroll
                for (int i = 0; i < 16; ++i) CAT[(size_t)(m0 + i0 + crow(i, h)) * 2048 + head * HD + 32 * dt + r] = (bf16)(pkbf(O[dt][i], 0.f) & 0xffffu);
#pragma unroll
            for (int kk = 0; kk < 4; ++kk) Qf[kk] = Qn[kk];
        }
    }
    LDS_BARRIER();
}

__device__ __forceinline__ void ph_ssd_mfma(const bf16* XBCC, const float* DT, const bf16* Z, const float* a_log, const float* d_skip, bf16* YG, float* SSG, LAS unsigned char* lds, int bid, int nblk, int tid_in) {
    constexpr int BS = 136, XS = 72;
    LAS bf16* Bs = (LAS bf16*)lds;
    LAS bf16* Cs = Bs + 128 * BS;
    LAS bf16* xs = Cs + 128 * BS;
    LAS bf16* xw = xs + 128 * XS;
    LAS bf16* Sb = xw + 128 * XS;
    LAS float* acum = (LAS float*)(Sb + 64 * BS);
    LAS float* dl = acum + 128;
    LAS float* wsd = dl + 128;
    LAS float* dtv = wsd + 128;
    constexpr int YS = 68;
    LAS float* ybuf = dtv + 128;
    LAS float* fsv = ybuf + 128 * YS;
    int tid = tid_in;
    const int lane = tid & 63, wave = __builtin_amdgcn_readfirstlane(tid >> 6), r = lane & 31, h = lane >> 5;
    const int orow = tid >> 2, ocg = (tid & 3) * 16;
    const int li = (int)((0x11002233u >> (4 * wave)) & 15u), hf = (int)((0x5Au >> wave) & 1u);
    const int sp_t = wave >> 2, sn_t = wave & 3;
    for (int unit = bid; unit < BATCH * M_HEADS; unit += nblk) {
        const int gg = (unit & 7) * 4 + (unit >> 6), b = gg >> 3, grp = gg & 7, hd = grp * 8 + ((unit >> 3) & 7); const float a = -expf(a_log[hd]), Dh = d_skip[hd];
        f32x16 Sacc;
#pragma unroll
        for (int i = 0; i < 16; ++i) Sacc[i] = 0.f;
        LDS_BARRIER();
        { unsigned on3 = ~0u; asm volatile("" : "+s"(on3));
          const int tz = wave * 64 + (int)__builtin_amdgcn_mbcnt_hi(on3, __builtin_amdgcn_mbcnt_lo(on3, 0u));
          for (int i = tz; i < 64 * BS / 2; i += 512) ((LAS unsigned*)Sb)[i] = 0u; }
        v4u nb[4], nc[4], nx[2]; float nd0, nd1;
        { const int m0 = b * SEQ;
#pragma unroll
          for (int i = 0; i < 4; ++i) { const int c = tid + 512 * i, row = c >> 4, c8 = (c & 15) * 8; const size_t go = (size_t)(m0 + row) * M_CONV_DIM + 4096 + grp * 128 + c8; nb[i] = *(const v4u*)(XBCC + go); nc[i] = *(const v4u*)(XBCC + go + 1024); }
#pragma unroll
          for (int i = 0; i < 2; ++i) { const int c = tid + 512 * i, row = c >> 3, c8 = (c & 7) * 8; nx[i] = *(const v4u*)(XBCC + (size_t)(m0 + row) * M_CONV_DIM + hd * 64 + c8); }
          nd0 = DT[(size_t)(m0 + 2 * lane) * 64 + hd]; nd1 = DT[(size_t)(m0 + 2 * lane + 1) * 64 + hd]; }
#pragma unroll 1
        for (int chunk = 0; chunk < SEQ / 128; ++chunk) {
            const int m0 = b * SEQ + chunk * 128;
#pragma unroll
            for (int i = 0; i < 4; ++i) { const int c = tid + 512 * i, row = c >> 4, c8 = (c & 15) * 8; *(LAS v4u*)(Bs + row * BS + c8) = nb[i]; *(LAS v4u*)(Cs + row * BS + c8) = nc[i]; }
            { const float d0 = nd0, d1 = nd1; const float v0 = a * d0, v1 = a * d1; float sc = v0 + v1;
#pragma unroll
              for (int o = 1; o < 64; o <<= 1) { const float t = __shfl_up(sc, o); if (lane >= o) sc += t; }
              const float c1 = sc, c0 = sc - v1; const float tot = __shfl(sc, 63);
              *(LAS f32x2v*)(acum + 2 * lane) = (f32x2v){c0, c1}; *(LAS f32x2v*)(dl + 2 * lane) = (f32x2v){__expf(c0), __expf(c1)};
              *(LAS f32x2v*)(wsd + 2 * lane) = (f32x2v){d0 * __expf(tot - c0), d1 * __expf(tot - c1)}; *(LAS f32x2v*)(dtv + 2 * lane) = (f32x2v){d0, d1};
              const float ce = __shfl(c1, lane | 15);
              *(LAS f32x2v*)(fsv + 2 * lane) = (f32x2v){d0 * __expf(ce - c0), d1 * __expf(ce - c1)}; }
#pragma unroll
            for (int i = 0; i < 2; ++i) { const int c = tid + 512 * i, row = c >> 3, c8 = (c & 7) * 8; const v4u w = nx[i]; const float f = wsd[row];
                *(LAS v4u*)(xs + row * XS + c8) = w;
                v4u o; o.x = pkbf(blo(w.x) * f, bhi(w.x) * f); o.y = pkbf(blo(w.y) * f, bhi(w.y) * f); o.z = pkbf(blo(w.z) * f, bhi(w.z) * f); o.w = pkbf(blo(w.w) * f, bhi(w.w) * f);
                *(LAS v4u*)(xw + row * XS + c8) = o; }
            if (chunk + 1 < SEQ / 128) { const int m1 = m0 + 128;
#pragma unroll
                for (int i = 0; i < 4; ++i) { const int c = tid + 512 * i, row = c >> 4, c8 = (c & 15) * 8; const size_t go = (size_t)(m1 + row) * M_CONV_DIM + 4096 + grp * 128 + c8; nb[i] = *(const v4u*)(XBCC + go); nc[i] = *(const v4u*)(XBCC + go + 1024); }
#pragma unroll
                for (int i = 0; i < 2; ++i) { const int c = tid + 512 * i, row = c >> 3, c8 = (c & 7) * 8; nx[i] = *(const v4u*)(XBCC + (size_t)(m1 + row) * M_CONV_DIM + hd * 64 + c8); }
                nd0 = DT[(size_t)(m1 + 2 * lane) * 64 + hd]; nd1 = DT[(size_t)(m1 + 2 * lane + 1) * 64 + hd]; }
            LDS_BARRIER();
            v4u zr[2];
            { const bf16* zp = Z + (size_t)(m0 + orow) * M_INNER + hd * 64 + ocg; zr[0] = *(const v4u*)zp; zr[1] = *(const v4u*)(zp + 8); }
            f32x16 acc[2];
#pragma unroll
            for (int i = 0; i < 16; ++i) { acc[0][i] = 0.f; acc[1][i] = 0.f; }
            {
                f32x16 a2;
#pragma unroll
                for (int i = 0; i < 16; ++i) a2[i] = 0.f;
#pragma unroll
                for (int kh = 0; kh < 2; ++kh) {
                    bf16x8v Cf[4], Xf[4];
#pragma unroll
                    for (int kk = 0; kk < 4; ++kk) { Cf[kk] = row_frag(Cs, BS, 32 * li + r, 64 * kh + 16 * kk + 8 * h); Xf[kk] = row_frag(Sb, BS, 32 * hf + r, 64 * kh + 16 * kk + 8 * h); }
                    __builtin_amdgcn_sched_barrier(0);
#pragma unroll
                    for (int kk = 0; kk < 4; ++kk) a2 = MFMA32(Cf[kk], Xf[kk], a2);
                }
#pragma unroll
                for (int i = 0; i < 16; ++i) { const int l = 32 * li + crow(i, h); a2[i] = a2[i] * dl[l] + Dh * bf2f(xs[l * XS + 32 * hf + r]); }
                if (hf) acc[1] = a2; else acc[0] = a2;
            }
            const int lcol = 32 * li + r; const float al = acum[lcol];
#pragma unroll 1
            for (int j = hf; j <= li; j += 2) {
                f32x16 T;
#pragma unroll
                for (int i = 0; i < 16; ++i) T[i] = 0.f;
#pragma unroll
                for (int kh = 0; kh < 2; ++kh) {
                    bf16x8v Cf[4], Xf[4];
#pragma unroll
                    for (int kk = 0; kk < 4; ++kk) { Xf[kk] = row_frag(Bs, BS, 32 * j + r, 64 * kh + 16 * kk + 8 * h); Cf[kk] = row_frag(Cs, BS, 32 * li + r, 64 * kh + 16 * kk + 8 * h); }
                    __builtin_amdgcn_sched_barrier(0);
#pragma unroll
                    for (int kk = 0; kk < 4; ++kk) T = MFMA32(Xf[kk], Cf[kk], T);
                }
                if (j < li) {
                    const float fl = __expf(al - acum[32 * j + 31]);
#pragma unroll
                    for (int q = 0; q < 4; ++q) { const f32x4 f4 = *(const LAS f32x4*)(fsv + 32 * j + 4 * h + 8 * q);
#pragma unroll
                        for (int k = 0; k < 4; ++k) T[4 * q + k] *= f4[k] * fl; }
                } else {
#pragma unroll
                    for (int q = 0; q < 4; ++q) { const f32x4 ac4 = *(const LAS f32x4*)(acum + 32 * j + 4 * h + 8 * q), dt4 = *(const LAS f32x4*)(dtv + 32 * j + 4 * h + 8 * q);
#pragma unroll
                        for (int k = 0; k < 4; ++k) { const int s = 32 * j + 8 * q + 4 * h + k; const float e = __expf(fminf(al - ac4[k], 0.f)) * dt4[k]; T[4 * q + k] *= (s <= lcol) ? e : 0.f; } }
                }
                const bf16x8v pa0 = pack8(T, 0), pa1 = pack8(T, 1); const int rowA = 32 * j + 4 * h;
#pragma unroll
                for (int pp = 0; pp < 2; ++pp) { const bf16x8v x0 = tr_frag(xs, XS, rowA, rowA + 8, 32 * pp, lane), x1 = tr_frag(xs, XS, rowA + 16, rowA + 24, 32 * pp, lane);
                    acc[pp] = MFMA32(pa0, x0, acc[pp]); acc[pp] = MFMA32(pa1, x1, acc[pp]); }
            }
            if (hf == 0) {
#pragma unroll
                for (int pp = 0; pp < 2; ++pp)
#pragma unroll
                    for (int i = 0; i < 16; ++i) ybuf[(32 * li + crow(i, h)) * YS + 32 * pp + r] = acc[pp][i];
            }
            { const float dtot = dl[127];
#pragma unroll
              for (int i = 0; i < 16; ++i) Sacc[i] *= dtot;
#pragma unroll
              for (int kh = 0; kh < 2; ++kh) { bf16x8v Af[4], Bf[4];
#pragma unroll
                  for (int kk = 0; kk < 4; ++kk) { const int rowA = 64 * kh + 16 * kk + 8 * h; Af[kk] = tr_frag(xw, XS, rowA, rowA + 4, 32 * sp_t, lane); Bf[kk] = tr_frag(Bs, BS, rowA, rowA + 4, 32 * sn_t, lane); }
                  __builtin_amdgcn_sched_barrier(0);
#pragma unroll
                  for (int kk = 0; kk < 4; ++kk) Sacc = MFMA32(Af[kk], Bf[kk], Sacc); } }
            LDS_BARRIER();
            if (hf == 1) {
#pragma unroll
                for (int pp = 0; pp < 2; ++pp)
#pragma unroll
                    for (int i = 0; i < 16; ++i) { LAS float* q = ybuf + (32 * li + crow(i, h)) * YS + 32 * pp + r; *q = *q + acc[pp][i]; }
            }
            LDS_BARRIER();
#pragma unroll
            for (int i = 0; i < 16; ++i) Sb[(32 * sp_t + crow(i, h)) * BS + 32 * sn_t + r] = (bf16)(pkbf(Sacc[i], 0.f) & 0xffffu);
            { const LAS f32x4* yp = (const LAS f32x4*)(ybuf + orow * YS + ocg);
              bf16* op = YG + ((size_t)(((m0 + orow) >> 8) * M_HEADS + hd) * 256 + ((m0 + orow) & 255)) * 64 + ocg;
              float qs = 0.f;
#pragma unroll
              for (int q = 0; q < 2; ++q) { const f32x4 y0 = yp[2 * q], y1 = yp[2 * q + 1]; const v4u zw = zr[q];
                  const float g0 = y0.x * siluf_(blo(zw.x)), g1 = y0.y * siluf_(bhi(zw.x)), g2 = y0.z * siluf_(blo(zw.y)), g3 = y0.w * siluf_(bhi(zw.y));
                  const float g4 = y1.x * siluf_(blo(zw.z)), g5 = y1.y * siluf_(bhi(zw.z)), g6 = y1.z * siluf_(blo(zw.w)), g7 = y1.w * siluf_(bhi(zw.w));
                  qs += ((g0 * g0 + g1 * g1) + (g2 * g2 + g3 * g3)) + ((g4 * g4 + g5 * g5) + (g6 * g6 + g7 * g7));
                  v4u o; o.x = pkbf(g0, g1); o.y = pkbf(g2, g3); o.z = pkbf(g4, g5); o.w = pkbf(g6, g7);
                  *(v4u*)(op + 8 * q) = o; }
              qs += __shfl_xor(qs, 1); qs += __shfl_xor(qs, 2);
              if ((tid & 3) == 0) SSG[(size_t)(m0 + orow) * 64 + hd] = qs; }
        }
    }
    LDS_BARRIER();
}

__device__ __forceinline__ void ph_s5_mfma(const CAS Params* PP, int e, const bf16* U, bf16* G, LAS unsigned char* lds, int bid, int nblk, int tid_in) {
    constexpr int BU = 132, HS = 136;
    LAS float* bu = (LAS float*)lds;
    LAS bf16* hs = (LAS bf16*)(bu + 2 * 64 * BU);
    int tid = tid_in;
    const int lane = tid & 63, wave = __builtin_amdgcn_readfirstlane(tid >> 6), r = lane & 31, h = lane >> 5;
    const float* a_re = ((const float*)(const GAS float*)PP->in[I_ARE]) + (size_t)e * 64 * 64; const float* a_im = ((const float*)(const GAS float*)PP->in[I_AIM]) + (size_t)e * 64 * 64;
    const float* log_dt = ((const float*)(const GAS float*)PP->in[I_LOGDT]) + (size_t)e * 64;
    const float* b_re = ((const float*)(const GAS float*)PP->in[I_BRE]) + (size_t)e * 64 * 64 * 16; const float* b_im = ((const float*)(const GAS float*)PP->in[I_BIM]) + (size_t)e * 64 * 64 * 16;
    const float* c_re = ((const float*)(const GAS float*)PP->in[I_CRE]) + (size_t)e * 64 * 16 * 64; const float* c_im = ((const float*)(const GAS float*)PP->in[I_CIM]) + (size_t)e * 64 * 16 * 64;
    const float* d_skip = ((const float*)(const GAS float*)PP->in[I_S5D]) + (size_t)e * 1024;
    for (int unit = bid; unit < BATCH * S5_GROUPS; unit += nblk) {
        const int b = unit >> 6, g = unit & 63; const float dt = expf(log_dt[g]);
        LDS_BARRIER();
        if (wave == 1 || wave == 2) {
            bf16x8v Bf[4];
#pragma unroll
            for (int kt = 0; kt < 4; ++kt) { const int k = 32 * kt + r, p = k >> 1, ri = k & 1;
                const float ar = a_re[g * 64 + p], ai = a_im[g * 64 + p]; const float mag = expf(ar * dt), abr = mag * cosf(ai * dt), abi = mag * sinf(ai * dt);
                const float nr = abr - 1.0f, ni = abi, den = ar * ar + ai * ai; const float cr = (nr * ar + ni * ai) / den, ci = (ni * ar - nr * ai) / den;
                float v[8];
#pragma unroll
                for (int j = 0; j < 8; ++j) { const float br = b_re[(size_t)(g * 64 + p) * 16 + 8 * h + j], bi = b_im[(size_t)(g * 64 + p) * 16 + 8 * h + j]; v[j] = ri ? (cr * bi + ci * br) : (cr * br - ci * bi); }
                v4u w; w.x = pkbf(v[0], v[1]); w.y = pkbf(v[2], v[3]); w.z = pkbf(v[4], v[5]); w.w = pkbf(v[6], v[7]); Bf[kt] = __builtin_bit_cast(bf16x8v, w); }
            const int tt = wave - 1;
            bf16x8v un = *(const bf16x8v*)(U + (size_t)(b * SEQ + 32 * tt + r) * S5_WIDTH + g * 16 + 8 * h);
#pragma unroll 1
            for (int i = 0; i < SEQ / 64 + 2; ++i) {
                if (i < SEQ / 64) {
                    const bf16x8v uc = un;
                    if (i + 1 < SEQ / 64) un = *(const bf16x8v*)(U + (size_t)(b * SEQ + (i + 1) * 64 + 32 * tt + r) * S5_WIDTH + g * 16 + 8 * h);
                    LAS float* dst = bu + (i & 1) * 64 * BU;
#pragma unroll
                    for (int kt = 0; kt < 4; ++kt) { f32x16 z;
#pragma unroll
                        for (int q = 0; q < 16; ++q) z[q] = 0.f;
                        const f32x16 d = MFMA32(uc, Bf[kt], z);
#pragma unroll
                        for (int q = 0; q < 16; ++q) dst[(32 * tt + crow(q, h)) * BU + 32 * kt + r] = d[q]; }
                }
                LDS_BARRIER();
            }
        } else if (wave == 0) {
            const int p = lane; const float ar = a_re[g * 64 + p], ai = a_im[g * 64 + p]; const float mag = expf(ar * dt), abr = mag * cosf(ai * dt), abi = mag * sinf(ai * dt);
            typedef float f2 __attribute__((ext_vector_type(2)));
            f2 hv = {0.f, 0.f}; const f2 av = {abr, abr}, bv = {-abi, abi};
#pragma unroll 1
            for (int i = 0; i < SEQ / 64 + 2; ++i) {
                if (i >= 1 && i <= SEQ / 64) {
                    const LAS float* src = bu + ((i - 1) & 1) * 64 * BU + 2 * p;
                    unsigned da = (unsigned)(size_t)(hs + ((i - 1) & 1) * 64 * HS + 2 * p); asm volatile("" : "+v"(da)); LAS bf16* dst = (LAS bf16*)(size_t)da;
                    f2 ba[16], bc[16];
#define S5_LD(arr, T0) _Pragma("unroll") for (int j = 0; j < 16; ++j) arr[j] = *(const LAS f2*)(src + ((T0) + j) * BU)
#define S5_PROC(arr, T0) _Pragma("unroll") for (int j = 0; j < 16; ++j) { const f2 sw = __builtin_shufflevector(hv, hv, 1, 0); const f2 t = __builtin_elementwise_fma(bv, sw, arr[j]); hv = __builtin_elementwise_fma(av, hv, t); \
                            *(LAS unsigned*)(dst + ((T0) + j) * HS) = pkbf(hv.x, hv.y); }
                    S5_LD(ba, 0); S5_LD(bc, 16); __builtin_amdgcn_sched_barrier(0);
                    S5_PROC(ba, 0); __builtin_amdgcn_sched_barrier(0); S5_LD(ba, 32); __builtin_amdgcn_sched_barrier(0);
                    S5_PROC(bc, 16); __builtin_amdgcn_sched_barrier(0); S5_LD(bc, 48); __builtin_amdgcn_sched_barrier(0);
                    S5_PROC(ba, 32); __builtin_amdgcn_sched_barrier(0);
                    S5_PROC(bc, 48);
#undef S5_LD
#undef S5_PROC
                }
                LDS_BARRIER();
            }
        } else if (wave == 3 || wave == 6) {
            bf16x8v Cf[8];
#pragma unroll
            for (int kk = 0; kk < 8; ++kk) { float v[8];
#pragma unroll
                for (int j = 0; j < 8; ++j) { const int k = 16 * kk + 8 * h + j, p = k >> 1; v[j] = (r < 16) ? ((k & 1) ? -c_im[(size_t)(g * 16 + (r & 15)) * 64 + p] : c_re[(size_t)(g * 16 + (r & 15)) * 64 + p]) : 0.f; }
                v4u w; w.x = pkbf(v[0], v[1]); w.y = pkbf(v[2], v[3]); w.z = pkbf(v[4], v[5]); w.w = pkbf(v[6], v[7]); Cf[kk] = __builtin_bit_cast(bf16x8v, w); }
            const int tt = (wave == 6) ? 1 : 0; const float dsk = d_skip[g * 16 + (r & 15)];
            unsigned short un[16];
#pragma unroll
            for (int q = 0; q < 16; ++q) un[q] = U[(size_t)(b * SEQ + 32 * tt + crow(q, h)) * S5_WIDTH + g * 16 + (r & 15)];
#pragma unroll 1
            for (int i = 0; i < SEQ / 64 + 2; ++i) {
                if (i >= 2) {
                    const int ch = i - 2; const LAS bf16* src = hs + (ch & 1) * 64 * HS; const int m0 = b * SEQ + ch * 64 + 32 * tt;
                    float uv[16];
#pragma unroll
                    for (int q = 0; q < 16; ++q) uv[q] = bf2f(un[q]);
                    if (ch + 1 < SEQ / 64) {
#pragma unroll
                        for (int q = 0; q < 16; ++q) un[q] = U[(size_t)(m0 + 64 + crow(q, h)) * S5_WIDTH + g * 16 + (r & 15)];
                    }
                    bf16x8v hf[8];
#pragma unroll
                    for (int kk = 0; kk < 8; ++kk) hf[kk] = row_frag(src, HS, 32 * tt + r, 16 * kk + 8 * h);
                    __builtin_amdgcn_sched_barrier(0);
                    f32x16 y;
#pragma unroll
                    for (int q = 0; q < 16; ++q) y[q] = 0.f;
#pragma unroll
                    for (int kk = 0; kk < 8; ++kk) y = MFMA32(hf[kk], Cf[kk], y);
                    if (r < 16) {
#pragma unroll
                        for (int q = 0; q < 16; ++q) G[(size_t)(m0 + crow(q, h)) * S5_WIDTH + g * 16 + r] = (bf16)(pkbf(gelu_tanh(y[q] + dsk * uv[q]), 0.f) & 0xffffu);
                    }
                }
                LDS_BARRIER();
            }
        } else {
#pragma unroll 1
            for (int i = 0; i < SEQ / 64 + 2; ++i) LDS_BARRIER();
        }
    }
    LDS_BARRIER();
}

struct CvtItem { const float* src; bf16* dst; const float* g; int N, K, il, off, tiled, kb; };
__device__ __forceinline__ void cvt_load(f32x4 (&v)[16], float (&gk)[16], const CvtItem& it, int lane) {
    const float* p = it.src + (size_t)(lane >> 4) * it.N + 4 * (lane & 15);
#pragma unroll
    for (int i = 0; i < 16; ++i) v[i] = *(const f32x4*)(p + (size_t)(4 * i) * it.N);
    if (it.g) {
#pragma unroll
        for (int i = 0; i < 16; ++i) gk[i] = it.g[4 * i + (lane >> 4)];
    } else {
#pragma unroll
        for (int i = 0; i < 16; ++i) gk[i] = 1.0f;
    }
}
__device__ __forceinline__ void cvt_process(const f32x4 (&v)[16], const float (&gk)[16], const CvtItem& it, int n0, LAS bf16* T1, LAS bf16* T2, int lane, int nostore = 0) {
    constexpr int TS = 72;
#pragma unroll
    for (int i = 0; i < 16; ++i) { v2u w; w.x = pkbf(v[i].x * gk[i], v[i].y * gk[i]); w.y = pkbf(v[i].z * gk[i], v[i].w * gk[i]); *(LAS v2u*)(T1 + (4 * i + (lane >> 4)) * TS + 4 * (lane & 15)) = w; }
    const int i16 = lane & 15, q = i16 >> 2, pp = i16 & 3, g = lane >> 4;
#pragma unroll
    for (int c = 0; c < 8; ++c) {
        const s16x4v lo = __builtin_amdgcn_ds_read_tr16_b64_v4i16((LAS s16x4v*)(T1 + (8 * c + q) * TS + 16 * g + 4 * pp));
        const s16x4v hi = __builtin_amdgcn_ds_read_tr16_b64_v4i16((LAS s16x4v*)(T1 + (8 * c + 4 + q) * TS + 16 * g + 4 * pp));
        *(LAS bf16x8v*)(T2 + lane * TS + 8 * c) = __builtin_shufflevector(lo, hi, 0, 1, 2, 3, 4, 5, 6, 7);
    }
#pragma unroll
    for (int t = 0; t < 8; ++t) { const int n = 8 * t + (lane >> 3), c = lane & 7; const v4u o = *(const LAS v4u*)(T2 + n * TS + 8 * c);
        const int nn = n0 + n; const int row = it.il ? ((nn >> 7) * 256 + (nn & 127) + it.off) : nn;
        bf16* p = it.tiled ? it.dst + ((size_t)((row >> 8) * (it.K >> 6) + it.kb) * 256 + (row & 255)) * 64 + 8 * c
                           : it.dst + (size_t)row * it.K + 64 * it.kb + 8 * c;
        if (!nostore || o.x == 0x12345678u) *(v4u*)p = o; }
}
__device__ __forceinline__ void ph_convert(const CAS Params* PP, int L, unsigned char* Wb, LAS unsigned char* lds, int gw, int NGW, int lane, int wave, int nostore = 0) {
    LAS bf16* T1 = (LAS bf16*)(lds + wave * 18432); LAS bf16* T2 = T1 + 64 * 72;
    const size_t fo = (size_t)L * D_MODEL * D_FF; const int eo = L >> 1; const bool even = (L & 1) == 0;
    constexpr int NF = 2816;
    const int n_mix = even ? (1280 + 256 + 1024) : (5152 + 2048);
    const int total = 6 * NF + n_mix;
    auto pick = [&](int idx, CvtItem& d, int& n0) {
        const float* W; bf16* WT; const float* gv = nullptr; int K, N, il = 0, off = 0, rel, tiled = 1;
        if (idx < 6 * NF) { const int mi = idx / NF; rel = idx - mi * NF;
            const int which = mi / 3, t = mi - 3 * which;
            if (t == 2) { W = (const float*)(const GAS float*)PP->in[which ? I_F2D : I_F1D] + fo; WT = (bf16*)(Wb + (which ? W_D1 : W_D0)); K = D_FF; N = D_MODEL; tiled = 1; }
            else { W = (const float*)(const GAS float*)PP->in[which ? (t ? I_F2U : I_F2G) : (t ? I_F1U : I_F1G)] + fo; WT = (bf16*)(Wb + (which ? W_GU1 : W_GU0)); K = D_MODEL; N = D_FF; il = 1; off = t ? 128 : 0;
                   gv = (const float*)(const GAS float*)PP->in[which ? I_NFFN2 : I_NFFN1] + (size_t)L * D_MODEL; }
        } else { rel = idx - 6 * NF;
            if (even) {
                if (rel < 1280) { W = (const float*)(const GAS float*)PP->in[I_EWIN] + (size_t)eo * D_MODEL * EVEN_IN; WT = (bf16*)(Wb + W_EIN); K = D_MODEL; N = EVEN_IN; gv = (const float*)(const GAS float*)PP->in[I_NMIX] + (size_t)L * D_MODEL; }
                else if (rel < 1280 + 256) { rel -= 1280; W = (const float*)(const GAS float*)PP->in[I_WGLU] + (size_t)eo * 1024 * 1024; WT = (bf16*)(Wb + W_EGLU); K = 1024; N = 1024; }
                else { rel -= 1280 + 256; W = (const float*)(const GAS float*)PP->in[I_EWOUT] + (size_t)eo * 2048 * 2048; WT = (bf16*)(Wb + W_EOUT); K = 2048; N = 2048; }
            } else {
                if (rel < 5152) { W = (const float*)(const GAS float*)PP->in[I_MWIN] + (size_t)eo * D_MODEL * M_IN; WT = (bf16*)(Wb + W_OIN); K = D_MODEL; N = M_IN; gv = (const float*)(const GAS float*)PP->in[I_NMIX] + (size_t)L * D_MODEL; }
                else { rel -= 5152; W = (const float*)(const GAS float*)PP->in[I_MWOUT] + (size_t)eo * M_INNER * D_MODEL; WT = (bf16*)(Wb + W_OOUT); K = M_INNER; N = D_MODEL; gv = (const float*)(const GAS float*)PP->in[I_MNORM] + (size_t)eo * M_INNER; }
            }
        }
        const int nblk = N >> 6, kb = rel / nblk, nb = rel - kb * nblk;
        d.src = W + (size_t)(64 * kb) * N + 64 * nb; d.dst = WT; d.tiled = tiled; d.kb = kb; d.N = N; d.K = K; d.il = il; d.off = off; d.g = gv ? gv + 64 * kb : nullptr; n0 = 64 * nb;
    };
    f32x4 va[16], vb[16]; float ga[16], gb[16]; CvtItem da, db; int na = 0, nbn = 0;
    int idx = gw;
    if (idx < total) { pick(idx, da, na); cvt_load(va, ga, da, lane); }
    while (idx < total) {
        const int i1 = idx + NGW, i2 = idx + 2 * NGW;
        if (i1 < total) { pick(i1, db, nbn); cvt_load(vb, gb, db, lane); }
        cvt_process(va, ga, da, na, T1, T2, lane, nostore);
        if (i1 < total) {
            if (i2 < total) { pick(i2, da, na); cvt_load(va, ga, da, lane); }
            cvt_process(vb, gb, db, nbn, T1, T2, lane, nostore);
        }
        idx = i2;
    }
}

__device__ __forceinline__ void ph_dt_mini(const bf16* XB, const bf16* Wdt, const float* SS, float* DT, LAS unsigned char* lds, int bid, int nblk, int tid_in) {
    constexpr int PS = 68;
    LAS float* part = (LAS float*)lds;
    int tid = tid_in;
    const int lane = tid & 63, wave = __builtin_amdgcn_readfirstlane(tid >> 6), r = lane & 31, h = lane >> 5;
    for (int job = bid; job < M_TOK / 64; job += nblk) {
        const int R0 = job * 64;
        const bf16* ap = XB + ((size_t)((R0 >> 8) * 32) * 256 + (R0 & 255) + r) * 64 + 8 * h;
        const bf16* bp = Wdt + (size_t)r * 64 + 8 * h;
        f32x16 acc[2][2];
#pragma unroll
        for (int i = 0; i < 16; ++i) { acc[0][0][i] = 0.f; acc[0][1][i] = 0.f; acc[1][0][i] = 0.f; acc[1][1][i] = 0.f; }
#pragma unroll 1
        for (int q = 0; q < 4; ++q) { const size_t ko = (size_t)(4 * wave + q) * 16384;
            bf16x8v af[4][2], bf[4][2];
#pragma unroll
            for (int ks = 0; ks < 4; ++ks)
#pragma unroll
                for (int t = 0; t < 2; ++t) { af[ks][t] = *(const bf16x8v*)(ap + ko + t * 2048 + ks * 16); bf[ks][t] = *(const bf16x8v*)(bp + ko + t * 2048 + ks * 16); }
#pragma unroll
            for (int ks = 0; ks < 4; ++ks)
#pragma unroll
                for (int rt = 0; rt < 2; ++rt)
#pragma unroll
                    for (int ct = 0; ct < 2; ++ct) acc[rt][ct] = MFMA32(af[ks][rt], bf[ks][ct], acc[rt][ct]);
        }
        LDS_BARRIER();
#pragma unroll
        for (int rt = 0; rt < 2; ++rt)
#pragma unroll
            for (int ct = 0; ct < 2; ++ct)
#pragma unroll
                for (int i = 0; i < 16; ++i) part[(wave * 64 + 32 * rt + crow(i, h)) * PS + 32 * ct + r] = acc[rt][ct][i];
        LDS_BARRIER();
        { const int row = tid >> 3, c8 = (tid & 7) * 8; f32x4 s0 = *(const LAS f32x4*)(part + row * PS + c8), s1 = *(const LAS f32x4*)(part + row * PS + c8 + 4);
#pragma unroll
          for (int w = 1; w < 8; ++w) { s0 += *(const LAS f32x4*)(part + (w * 64 + row) * PS + c8); s1 += *(const LAS f32x4*)(part + (w * 64 + row) * PS + c8 + 4); }
          const f32x4 sp = *(const f32x4*)(SS + (size_t)(R0 + row) * 32 + 4 * (tid & 7)); float t = (sp[0] + sp[1]) + (sp[2] + sp[3]);
          t += __shfl_xor(t, 1); t += __shfl_xor(t, 2); t += __shfl_xor(t, 4);
          const float sc = __builtin_amdgcn_rsqf(t * (1.0f / 2048.0f) + 1e-5f);
          float* op = DT + (size_t)(R0 + row) * 64 + c8; *(f32x4*)op = s0 * sc; *(f32x4*)(op + 4) = s1 * sc; }
    }
    LDS_BARRIER();
}
constexpr int NPH = 37 + 8 * ((PROBE_MASK >> 3) & 1) + 8 * ((PROBE_MASK >> 4) & 1) + 4 * ((PROBE_MASK >> 5) & 1) + 6 * ((PROBE_MASK >> 8) & 1) + 40 * ((PROBE_MASK >> 18) & 1);
__global__ void __launch_bounds__(512, 2) k_fwd(Params P) {
    extern __shared__ __attribute__((aligned(16))) unsigned char lds_raw[];
    LAS unsigned char* lds = (LAS unsigned char*)lds_raw;
    unsigned char* ws = P.ws;
    volatile LAS unsigned* MISC = (volatile LAS unsigned*)(lds + MISC_OFF);
    const int WV = __builtin_amdgcn_readfirstlane((int)threadIdx.x >> 6);
    if (threadIdx.x < 16) MISC[threadIdx.x] = 0u;
    __syncthreads();
    XcdBarrier bar; bar.bar = (unsigned*)(ws + WS_CTL) + CW_BAR; bar.x = 0; bar.st = MISC; bar.lead = false;
    if (P.hi - P.lo > 1) bar = xcd_barrier_post((unsigned*)(ws + WS_CTL) + CW_BAR, MISC);
    int ph = 0;
#define PH_BEGIN if (ph >= P.lo && ph < P.hi) { unsigned ones = ~0u; asm volatile("" : "+s"(ones)); int tid = WV * 64 + (int)__builtin_amdgcn_mbcnt_hi(ones, __builtin_amdgcn_mbcnt_lo(ones, 0u)); int bid = blockIdx.x, G = gridDim.x; asm volatile("" : "+s"(bid), "+s"(G)); \
    const int lane = tid & 63, wave = __builtin_amdgcn_readfirstlane(tid >> 6), gw = bid * 8 + wave, gtid = bid * 512 + tid, NGW = G * 8, gthreads = G * 512; (void)lane; (void)gw; (void)gtid; (void)NGW; (void)gthreads; \
    const CAS Params* PP = (const CAS Params*)__builtin_amdgcn_kernarg_segment_ptr(); asm volatile("" : "+s"(PP)); unsigned char* ws = (unsigned char*)(GAS unsigned char*)PP->ws; \
    float* X = (float*)(ws + WS_X); bf16* XN = (bf16*)(ws + WS_XN); float* ROT = (float*)(ws + WS_ROT); unsigned char* R = ws + WS_R; unsigned char* Wb = ws + WS_W; float* SSb = (float*)(ws + WS_SS); (void)SSb; float* SSGb = (float*)(ws + WS_SSG); (void)SSGb; float* DUMMY = (float*)(ws + WS_END); (void)X; (void)XN; (void)ROT; (void)R; (void)Wb; (void)DUMMY;
#define PH_END   if (ph + 1 < P.hi) { XcdBarrier bb = bar; unsigned boff = CW_BAR; asm volatile("" : "+s"(boff)); bb.bar = (unsigned*)(P.ws + WS_CTL) + boff; unsigned on2 = ~0u; asm volatile("" : "+s"(on2)); bb.lead = (WV == 0) && (__builtin_amdgcn_mbcnt_hi(on2, __builtin_amdgcn_mbcnt_lo(on2, 0u)) == 0u); xcd_barrier(bb); } } ++ph;
#define REP_BEGIN(kind) for (int rep = ((PROBE_MASK >> (kind)) & 1) ? 0 : 1; rep < 2; ++rep) {
#define REP_END }
#define INF(i) ((const float*)(const GAS float*)PP->in[i])
#define OUTP ((float*)(GAS float*)PP->out)

#define Qb ((bf16*)(R + R_Q))
#define Kb ((bf16*)(R + R_K))
#define Vb ((bf16*)(R + R_V))
#define Ub ((bf16*)(R + R_U))
#define Gb ((bf16*)(R + R_G))
#define CATb ((bf16*)(R + R_CAT))
#define Zb ((bf16*)(R + R_Z))
#define XBCb ((bf16*)(R + R_XBC))
#define XBCCb ((bf16*)(R + R_XBCC))
#define YGb ((bf16*)(R + R_YG))
#define YNb ((bf16*)(R + R_YN))
#define DTb ((float*)(R + R_DT))

#pragma unroll 1
    for (int fi = 0; fi < 2 * DEPTH; ++fi) {
        const int L = fi >> 1, which = fi & 1;
        if (which == 0) {
            PH_BEGIN
                if (L == 0) {
                    const int* pos = (const int*)(const GAS int*)PP->in[I_POS];
                    for (int i = gtid; i < M_TOK * 8; i += gthreads) { const int m = i >> 3, j = i & 7; float a = -13.122363377404328f * (float)j; a = a * 0.125f; const float ang = (float)pos[m] * expf(a);
                        ROT[m * 16 + j] = cosf(ang); ROT[m * 16 + 8 + j] = sinf(ang); }
                    ph_xb_ss(INF(I_X), XN, SSb, gw, NGW, lane);
                }
                REP_BEGIN(1)
                ph_convert(PP, L, Wb, lds, gw, NGW, lane, wave, (PROBE_MASK & 0x10000) ? (rep == 0) : 0);
                if ((L & 1) == 1) {
                    { unsigned z0 = 0u; asm volatile("" : "+v"(z0));
                      for (int i = gtid; i < 32 * 1536; i += gthreads) { const int kt = i / 1536, w16 = i - kt * 1536;
                          *(v4u*)(Wb + W_OIN + ((size_t)(40 * 32 + kt) * 256 + 64) * 128 + (size_t)w16 * 16) = (v4u){z0, z0, z0, z0}; } }
                }
            REP_END PH_END
        }
#define xsrc ((fi == 0) ? INF(I_X) : (const float*)X)
#if (PROBE_MASK >> 3) & 1
        PH_BEGIN { constexpr int rep = 0;
            pg8::Gemm g{XN, (const bf16*)(Wb + (which ? W_GU1 : W_GU0)), M_TOK, 2 * D_FF, D_MODEL}; pg8::StaticOrder S; S.init(M_TOK, 2 * D_FF, G, bid);
            pg8::stage_row_scales(lds, SSb, S, tid);
            pg8::EpiSwiGLU E{(bf16*)(R + R_H), D_FF, lds};
            pg8::gemm_phase<pg8::EpiSwiGLU, pg8::StaticOrder, true, true, true, true>(lds, g, S, E, tid);
        } PH_END
#endif
        PH_BEGIN { constexpr int rep = 1; (void)rep;
            pg8::Gemm g{XN, (const bf16*)(Wb + (which ? W_GU1 : W_GU0)), M_TOK, 2 * D_FF, D_MODEL}; pg8::StaticOrder S; S.init(M_TOK, 2 * D_FF, G, bid);
            pg8::stage_row_scales(lds, SSb, S, tid);
            pg8::EpiSwiGLU E{(bf16*)(R + R_H), D_FF, lds};
            pg8::gemm_phase<pg8::EpiSwiGLU, pg8::StaticOrder, true, true, true, true>(lds, g, S, E, tid);
        } PH_END
#if (PROBE_MASK >> 4) & 1
        PH_BEGIN { constexpr int rep = 0;
            pg8::Gemm g{(const bf16*)(R + R_H), (const bf16*)(Wb + (which ? W_D1 : W_D0)), M_TOK, D_MODEL, D_FF}; pg8::MaskOrder S; S.init(M_TOK, D_MODEL, G, bid, 4); S.mask = (PROBE_MASK & 0x20000) ? 7 : 63;
            pg8::EpiResid E{XN, (bf16*)DUMMY, DUMMY + (size_t)M_TOK * D_MODEL, D_MODEL, 1, lds};
            pg8::gemm_phase<pg8::EpiResid, pg8::MaskOrder, true, true, true, true>(lds, g, S, E, tid);
        } PH_END
#endif
        PH_BEGIN { constexpr int rep = 1; (void)rep;
            pg8::Gemm g{(const bf16*)(R + R_H), (const bf16*)(Wb + (which ? W_D1 : W_D0)), M_TOK, D_MODEL, D_FF}; pg8::StaticOrder S; S.init(M_TOK, D_MODEL, G, bid, 4);
            pg8::EpiResid E{XN, rep ? XN : (bf16*)DUMMY, rep ? SSb : DUMMY + (size_t)M_TOK * D_MODEL, D_MODEL, 1, lds};
            pg8::gemm_phase<pg8::EpiResid, pg8::StaticOrder, true, true, true, true>(lds, g, S, E, tid);
        } PH_END
        if (which == 0) {
            const int eo = L >> 1;
            if ((L & 1) == 0) {
#if (PROBE_MASK >> 5) & 1
                PH_BEGIN { constexpr int rep = 0;
                    pg8::Gemm g{XN, (const bf16*)(Wb + W_EIN), M_TOK, EVEN_IN, D_MODEL}; pg8::StaticOrder S; S.init(M_TOK, EVEN_IN, G, bid);
                    pg8::stage_row_scales(lds, SSb, S, tid);
                    pg8::EpiEvenIn E{Qb, Kb, Vb, Ub, ROT, lds};
                    pg8::gemm_phase<pg8::EpiEvenIn, pg8::StaticOrder, true, true, true, true>(lds, g, S, E, tid);
                } PH_END
#endif
                PH_BEGIN { constexpr int rep = 1; (void)rep;
                    pg8::Gemm g{XN, (const bf16*)(Wb + W_EIN), M_TOK, EVEN_IN, D_MODEL}; pg8::StaticOrder S; S.init(M_TOK, EVEN_IN, G, bid);
                    pg8::stage_row_scales(lds, SSb, S, tid);
                    pg8::EpiEvenIn E{Qb, Kb, Vb, Ub, ROT, lds};
                    pg8::gemm_phase<pg8::EpiEvenIn, pg8::StaticOrder, true, true, true, true>(lds, g, S, E, tid);
                } PH_END
                PH_BEGIN
                REP_BEGIN(6)
                    ph_attn_mfma(Qb, Kb, Vb, INF(I_SINK) + eo * A_HEADS, CATb, lds, bid, G, tid);
                REP_END
                REP_BEGIN(10)
                    ph_s5_mfma(PP, eo, Ub, Gb, lds, bid, G, tid);
                REP_END
                PH_END
#if (PROBE_MASK >> 8) & 1
                PH_BEGIN { constexpr int rep = 0;
                    pg8::Gemm g{Gb, (const bf16*)(Wb + W_EGLU), M_TOK, 1024, 1024}; pg8::StaticOrder S; S.init(M_TOK, 1024, G, bid);
                    pg8::EpiGLU E{Gb, INF(I_BGLU) + (size_t)eo * 1024, CATb};
                    pg8::gemm_phase<pg8::EpiGLU, pg8::StaticOrder, true, true, false, true>(lds, g, S, E, tid);
                } PH_END
#endif
                PH_BEGIN { constexpr int rep = 1; (void)rep;
                    pg8::Gemm g{Gb, (const bf16*)(Wb + W_EGLU), M_TOK, 1024, 1024}; pg8::StaticOrder S; S.init(M_TOK, 1024, G, bid);
                    pg8::EpiGLU E{Gb, INF(I_BGLU) + (size_t)eo * 1024, CATb};
                    pg8::gemm_phase<pg8::EpiGLU, pg8::StaticOrder, true, true, false, true>(lds, g, S, E, tid);
                } PH_END
#if (PROBE_MASK >> 8) & 1
                PH_BEGIN { constexpr int rep = 0;
                    pg8::Gemm g{CATb, (const bf16*)(Wb + W_EOUT), M_TOK, D_MODEL, 2048}; pg8::StaticOrder S; S.init(M_TOK, D_MODEL, G, bid, 4);
                    pg8::EpiResid E{XN, rep ? XN : (bf16*)DUMMY, rep ? SSb : DUMMY + (size_t)M_TOK * D_MODEL, D_MODEL, 0, lds};
                    pg8::gemm_phase<pg8::EpiResid, pg8::StaticOrder, true, true, false, true>(lds, g, S, E, tid);
                } PH_END
#endif
                PH_BEGIN { constexpr int rep = 1; (void)rep;
                    pg8::Gemm g{CATb, (const bf16*)(Wb + W_EOUT), M_TOK, D_MODEL, 2048}; pg8::StaticOrder S; S.init(M_TOK, D_MODEL, G, bid, 4);
                    pg8::EpiResid E{XN, rep ? XN : (bf16*)DUMMY, rep ? SSb : DUMMY + (size_t)M_TOK * D_MODEL, D_MODEL, 0, lds};
                    pg8::gemm_phase<pg8::EpiResid, pg8::StaticOrder, true, true, false, true>(lds, g, S, E, tid);
                } PH_END
            } else {
#if (PROBE_MASK >> 5) & 1
                PH_BEGIN { constexpr int rep = 0;
                    pg8::Gemm g{XN, (const bf16*)(Wb + W_OIN), M_TOK, M_IN_PAD, D_MODEL}; pg8::StaticOrder S; S.init(M_TOK, M_IN_PAD, G, bid);
                    pg8::stage_row_scales(lds, SSb, S, tid);
                    pg8::EpiOddIn E{Zb, XBCb, DTb, lds};
                    pg8::gemm_phase<pg8::EpiOddIn, pg8::StaticOrder, true, true, true, true>(lds, g, S, E, tid);
                } PH_END
#endif
                PH_BEGIN { constexpr int rep = 1; (void)rep;
                    ph_dt_mini(XN, (const bf16*)(Wb + W_OIN) + (size_t)40 * 32 * 16384, SSb, DTb, lds, bid, G, tid);
                    pg8::Gemm g{XN, (const bf16*)(Wb + W_OIN), M_TOK, 40 * 256, D_MODEL}; pg8::StaticOrder S; S.init(M_TOK, 40 * 256, G, bid);
                    pg8::stage_row_scales(lds, SSb, S, tid);
                    pg8::EpiOddIn E{Zb, XBCb, DTb, lds};
                    pg8::gemm_phase<pg8::EpiOddIn, pg8::StaticOrder, true, true, true, true>(lds, g, S, E, tid);
                } PH_END
                PH_BEGIN REP_BEGIN(7)
                    ph_conv(rep,XBCb, INF(I_CONVW) + (size_t)eo * 4 * M_CONV_DIM, INF(I_CONVB) + (size_t)eo * M_CONV_DIM, INF(I_DTB) + eo * 64, XBCCb, DTb, gw, NGW, lane, gtid, gthreads);
                REP_END PH_END
                PH_BEGIN REP_BEGIN(9)
#if USE_MFMA_SSD
                    ph_ssd_mfma(XBCCb, DTb, Zb, INF(I_ALOG) + eo * 64, INF(I_MD) + eo * 64, YGb, SSGb, lds, bid, G, tid);
#else
                    ph_ssd_naive(XBCCb, DTb, Zb, INF(I_ALOG) + eo * 64, INF(I_MD) + eo * 64, YGb, SSGb, lds, bid, G, tid);
#endif
                REP_END PH_END
#if (PROBE_MASK >> 8) & 1
                PH_BEGIN { constexpr int rep = 0;
                    pg8::Gemm g{YGb, (const bf16*)(Wb + W_OOUT), M_TOK, D_MODEL, M_INNER}; pg8::StaticOrder S; S.init(M_TOK, D_MODEL, G, bid, 4);
                    pg8::stage_group_scales(lds, SSGb, S, tid);
                    pg8::EpiResid E{XN, rep ? XN : (bf16*)DUMMY, rep ? SSb : DUMMY + (size_t)M_TOK * D_MODEL, D_MODEL, 2, lds};
                    pg8::gemm_phase<pg8::EpiResid, pg8::StaticOrder, true, true, true, true, true>(lds, g, S, E, tid);
                } PH_END
#endif
                PH_BEGIN { constexpr int rep = 1; (void)rep;
                    pg8::Gemm g{YGb, (const bf16*)(Wb + W_OOUT), M_TOK, D_MODEL, M_INNER}; pg8::StaticOrder S; S.init(M_TOK, D_MODEL, G, bid, 4);
                    pg8::stage_group_scales(lds, SSGb, S, tid);
                    pg8::EpiResid E{XN, rep ? XN : (bf16*)DUMMY, rep ? SSb : DUMMY + (size_t)M_TOK * D_MODEL, D_MODEL, 2, lds};
                    pg8::gemm_phase<pg8::EpiResid, pg8::StaticOrder, true, true, true, true, true>(lds, g, S, E, tid);
                } PH_END
            }
        }
    }
#if PROBE_MASK & 0x40000
    for (int e = 0; e < 40; ++e) { PH_BEGIN PH_END }
#endif
    PH_BEGIN REP_BEGIN(2)
        ph_rmsnorm_out(XN, INF(I_FNORM), OUTP, gw, NGW, lane);
    REP_END PH_END
#undef PH_BEGIN
#undef PH_END
}

extern "C" void kernel_launch(void* const* d_in, const int* in_sizes, int n_in, void* d_out, int out_size, void* d_ws, size_t ws_size, hipStream_t stream) {
    static int grid = 0;
    if (grid == 0) {
        if (n_in != 33 || in_sizes[0] != M_TOK * D_MODEL || out_size != M_TOK * D_MODEL || ws_size < WS_END) { fprintf(stderr, "kernel_launch: unexpected shapes (n_in %d, ws %zu < %zu?)\n", n_in, ws_size, (size_t)WS_END); grid = -1; return; }
        int dev = 0, cus = 0;
        if (hipGetDevice(&dev) != hipSuccess || hipDeviceGetAttribute(&cus, hipDeviceAttributeMultiprocessorCount, dev) != hipSuccess) { grid = -1; return; }
        if (hipFuncSetAttribute((const void*)k_fwd, hipFuncAttributeMaxDynamicSharedMemorySize, LDS_BYTES) != hipSuccess) { fprintf(stderr, "kernel_launch: hipFuncSetAttribute failed\n"); grid = -1; return; }
        int per_cu = 0;
        if (hipOccupancyMaxActiveBlocksPerMultiprocessor(&per_cu, (const void*)k_fwd, 512, LDS_BYTES) != hipSuccess || per_cu < 1) fprintf(stderr, "kernel_launch: occupancy query reports %d\n", per_cu);
        (void)hipGetLastError();
        grid = cus;
    }
    if (grid < 0) return;
    (void)hipMemsetAsync((char*)d_ws + WS_CTL, 0, CTL_ZERO_BYTES, stream);
    Params p{};
    for (int i = 0; i < 33; ++i) p.in[i] = d_in[i];
    p.out = (float*)d_out; p.ws = (unsigned char*)d_ws;
#if MK_ONE_LAUNCH
    p.lo = 0; p.hi = NPH;
    hipLaunchKernelGGL(k_fwd, dim3(grid), dim3(512), LDS_BYTES, stream, p);
#else
    for (int ph = 0; ph < NPH; ++ph) { p.lo = ph; p.hi = ph + 1; hipLaunchKernelGGL(k_fwd, dim3(grid), dim3(512), LDS_BYTES, stream, p); }
#endif
}
```
